# Optimizing an MI355X kernel written in HIP

```python
import jax, jax.numpy as jnp
from jax import lax
import numpy as np

D_MODEL = 1024
BATCH = 32
SEQ = 2048
DEPTH = 1

N_Q_HEADS = 16
N_KV_HEADS = 4
HEAD_DIM = 64
WINDOW = 128
ATTN_BLOCK = 128
ROPE_THETA = 10000.0
LRU_WIDTH = D_MODEL
LRU_BLOCKS = 8
LRU_BLOCK_W = LRU_WIDTH // LRU_BLOCKS
CONV_WIDTH = 4
LRU_C = 8.0
LRU_MIN_RAD = 0.9
LRU_MAX_RAD = 0.999
N_EXPERTS = 32
TOP_K = 4
D_FF = D_MODEL
SWIGLU_LIMIT = 7.0
SWIGLU_ALPHA = 1.702
MOE_BLOCK = 256
EPS = 1e-6

Q_W = N_Q_HEADS * HEAD_DIM
KV_W = N_KV_HEADS * HEAD_DIM
IN_W = Q_W + 2 * KV_W + 2 * LRU_WIDTH + 2 * D_MODEL

kernel_name = "hybrid_swa_rglru_moe_block"


def rms_norm(x, g):
    xf = x.astype(jnp.float32)
    xf = xf * lax.rsqrt(jnp.mean(xf * xf, axis=-1, keepdims=True) + EPS)
    return (xf * g.astype(jnp.float32)).astype(x.dtype)


def rope(t, positions):
    inv_freq = ROPE_THETA ** (-jnp.arange(0, HEAD_DIM, 2, dtype=jnp.float32) / HEAD_DIM)
    ang = positions.astype(jnp.float32)[..., None] * inv_freq
    cos = jnp.cos(ang)[:, :, None, :]
    sin = jnp.sin(ang)[:, :, None, :]
    tf = t.astype(jnp.float32)
    t1, t2 = jnp.split(tf, 2, axis=-1)
    return jnp.concatenate([t1 * cos - t2 * sin, t2 * cos + t1 * sin], axis=-1).astype(t.dtype)


def banded_sink_attention(q, k, v, sinks):
    B, S = q.shape[0], q.shape[1]
    nb = S // ATTN_BLOCK
    G = N_Q_HEADS // N_KV_HEADS
    qb = q.reshape(B, nb, ATTN_BLOCK, N_KV_HEADS, G, HEAD_DIM)

    def windows(t):
        tp = jnp.pad(t, ((0, 0), (ATTN_BLOCK, 0), (0, 0), (0, 0)))
        prev = tp[:, :S].reshape(B, nb, ATTN_BLOCK, N_KV_HEADS, HEAD_DIM)
        cur = t.reshape(B, nb, ATTN_BLOCK, N_KV_HEADS, HEAD_DIM)
        return jnp.concatenate([prev, cur], axis=2)

    kw, vw = windows(k), windows(v)
    s = jnp.einsum("bnqhgd,bnkhd->bnhgqk", qb, kw).astype(jnp.float32) * (HEAD_DIM ** -0.5)
    blk = jnp.arange(nb)[:, None, None] * ATTN_BLOCK
    qpos = blk + jnp.arange(ATTN_BLOCK)[None, :, None]
    kpos = blk - ATTN_BLOCK + jnp.arange(2 * ATTN_BLOCK)[None, None, :]
    rel = qpos - kpos
    valid = (rel >= 0) & (rel < WINDOW) & (kpos >= 0)
    s = jnp.where(valid[None, :, None, None, :, :], s, -jnp.inf)
    sink = sinks.astype(jnp.float32).reshape(1, 1, N_KV_HEADS, G, 1, 1)
    m = jnp.maximum(jnp.max(s, axis=-1, keepdims=True), sink)
    p = jnp.exp(s - m)
    denom = jnp.sum(p, axis=-1, keepdims=True) + jnp.exp(sink - m)
    o = jnp.einsum("bnhgqk,bnkhd->bnqhgd", (p / denom).astype(v.dtype), vw)
    return o.reshape(B, S, Q_W)


def causal_depthwise_conv(x, w, b):
    S = x.shape[1]
    xp = jnp.pad(x, ((0, 0), (CONV_WIDTH - 1, 0), (0, 0)))
    out = b
    for tap in range(CONV_WIDTH):
        out = out + xp[:, tap:tap + S] * w[tap]
    return out


def rg_lru(x, w_rg, b_rg, w_ig, b_ig, lru_a):
    B, S = x.shape[0], x.shape[1]
    xb = x.reshape(B, S, LRU_BLOCKS, LRU_BLOCK_W)
    r = jax.nn.sigmoid(jnp.einsum("bsnd,nde->bsne", xb, w_rg).reshape(B, S, LRU_WIDTH) + b_rg)
    i = jax.nn.sigmoid(jnp.einsum("bsnd,nde->bsne", xb, w_ig).reshape(B, S, LRU_WIDTH) + b_ig)
    log_a = -LRU_C * r.astype(jnp.float32) * jax.nn.softplus(lru_a.astype(jnp.float32))
    a = jnp.exp(log_a)
    mult = jnp.sqrt(-jnp.expm1(2.0 * log_a))
    u = mult * (i * x).astype(jnp.float32)

    def combine(left, right):
        a1, b1 = left
        a2, b2 = right
        return a1 * a2, a2 * b1 + b2

    _, h = lax.associative_scan(combine, (a, u), axis=1)
    return h.astype(x.dtype)


def hybrid_mixer(h, positions, w_in, b_in, sinks, conv_w, conv_b, w_rg, b_rg, w_ig, b_ig, lru_a, w_out, b_out):
    B, S = h.shape[0], h.shape[1]
    proj = h @ w_in + b_in
    o1 = Q_W
    o2 = o1 + KV_W
    o3 = o2 + KV_W
    o4 = o3 + LRU_WIDTH
    o5 = o4 + LRU_WIDTH
    o6 = o5 + D_MODEL
    q, k, v, lx, ly, ga, gl = jnp.split(proj, [o1, o2, o3, o4, o5, o6], axis=-1)
    q = rope(q.reshape(B, S, N_Q_HEADS, HEAD_DIM), positions)
    k = rope(k.reshape(B, S, N_KV_HEADS, HEAD_DIM), positions)
    v = v.reshape(B, S, N_KV_HEADS, HEAD_DIM)
    attn = banded_sink_attention(q, k, v, sinks)
    lx = causal_depthwise_conv(lx, conv_w, conv_b)
    lru = rg_lru(lx, w_rg, b_rg, w_ig, b_ig, lru_a) * jax.nn.gelu(ly, approximate=True)
    merged = jax.nn.sigmoid(ga) * attn + jax.nn.sigmoid(gl) * lru
    return merged @ w_out + b_out


def moe_ffn(h, w_router, b_router, w_e1, b_e1, w_e2, b_e2):
    T, D = h.shape
    logits = h.astype(jnp.float32) @ w_router.astype(jnp.float32) + b_router.astype(jnp.float32)
    top_v, top_i = lax.top_k(logits, TOP_K)
    top_w = jax.nn.softmax(top_v, axis=-1)
    N = T * TOP_K
    flat_e = top_i.reshape(-1)
    flat_w = top_w.reshape(-1)
    flat_tok = jnp.arange(N, dtype=jnp.int32) // TOP_K
    order = jnp.argsort(flat_e, stable=True)
    se = flat_e[order]
    counts = jnp.bincount(flat_e, length=N_EXPERTS)
    starts = jnp.cumsum(counts) - counts
    pcounts = (counts + MOE_BLOCK - 1) // MOE_BLOCK * MOE_BLOCK
    pends = jnp.cumsum(pcounts)
    pstarts = pends - pcounts
    dest = pstarts[se] + (jnp.arange(N) - starts[se])
    n_blocks = N // MOE_BLOCK + N_EXPERTS
    n_slots = n_blocks * MOE_BLOCK
    blk_expert = jnp.minimum(jnp.searchsorted(pends, jnp.arange(n_blocks) * MOE_BLOCK, side="right"), N_EXPERTS - 1)
    src_tok = jnp.full((n_slots,), T, jnp.int32).at[dest].set(flat_tok[order])
    slot_w = jnp.zeros((n_slots,), jnp.float32).at[dest].set(flat_w[order])
    h_pad = jnp.concatenate([h, jnp.zeros((1, D), h.dtype)], axis=0)

    def expert_block(args):
        idx, wts, e = args
        xb = h_pad[idx]
        gu = xb @ w_e1[e] + b_e1[e]
        g, u = jnp.split(gu, 2, axis=-1)
        g = jnp.minimum(g, SWIGLU_LIMIT)
        u = jnp.clip(u, -SWIGLU_LIMIT, SWIGLU_LIMIT)
        act = g * jax.nn.sigmoid(SWIGLU_ALPHA * g) * (u + 1.0)
        out = act @ w_e2[e] + b_e2[e]
        return out * wts.astype(out.dtype)[:, None]

    yp = lax.map(expert_block, (src_tok.reshape(n_blocks, MOE_BLOCK), slot_w.reshape(n_blocks, MOE_BLOCK), blk_expert))
    y = jnp.zeros((T + 1, D), yp.dtype).at[src_tok].add(yp.reshape(n_slots, D))
    return y[:T]


def setup_inputs(seed: int = 0) -> dict:
    key = jax.random.key(seed)
    ks = jax.random.split(key, 32)
    f32 = jnp.float32
    nrm = lambda k, shape, scale: jax.random.normal(k, shape, f32) * scale
    x = nrm(ks[0], (BATCH, SEQ, D_MODEL), 1.0)
    c = nrm(ks[1], (BATCH, D_MODEL), 1.0)
    offs = jax.random.randint(ks[2], (BATCH, 1), 0, SEQ, dtype=jnp.int32)
    positions = (jnp.arange(SEQ, dtype=jnp.int32)[None, :] + offs).astype(jnp.int32)
    u = jax.random.uniform(ks[3], (DEPTH, LRU_WIDTH), f32, LRU_MIN_RAD ** 2, LRU_MAX_RAD ** 2)
    lru_a = jnp.log(jnp.expm1(-0.5 * jnp.log(u)))
    return {
        "x": x,
        "c": c,
        "positions": positions,
        "w_ada": nrm(ks[4], (DEPTH, D_MODEL, 6 * D_MODEL), 0.5 * D_MODEL ** -0.5),
        "b_ada": nrm(ks[5], (DEPTH, 6 * D_MODEL), 0.01),
        "g_pre_mix": 1.0 + nrm(ks[6], (DEPTH, D_MODEL), 0.01),
        "g_post_mix": 1.0 + nrm(ks[7], (DEPTH, D_MODEL), 0.01),
        "w_in": nrm(ks[8], (DEPTH, D_MODEL, IN_W), D_MODEL ** -0.5),
        "b_in": nrm(ks[9], (DEPTH, IN_W), 0.01),
        "sinks": nrm(ks[10], (DEPTH, N_Q_HEADS), 0.5),
        "conv_w": nrm(ks[11], (DEPTH, CONV_WIDTH, LRU_WIDTH), CONV_WIDTH ** -0.5),
        "conv_b": nrm(ks[12], (DEPTH, LRU_WIDTH), 0.01),
        "w_rg": nrm(ks[13], (DEPTH, LRU_BLOCKS, LRU_BLOCK_W, LRU_BLOCK_W), LRU_BLOCK_W ** -0.5),
        "b_rg": nrm(ks[14], (DEPTH, LRU_WIDTH), 0.01),
        "w_ig": nrm(ks[15], (DEPTH, LRU_BLOCKS, LRU_BLOCK_W, LRU_BLOCK_W), LRU_BLOCK_W ** -0.5),
        "b_ig": nrm(ks[16], (DEPTH, LRU_WIDTH), 0.01),
        "lru_a": lru_a,
        "w_out": nrm(ks[17], (DEPTH, D_MODEL, D_MODEL), D_MODEL ** -0.5),
        "b_out": nrm(ks[18], (DEPTH, D_MODEL), 0.01),
        "g_pre_ffn": 1.0 + nrm(ks[19], (DEPTH, D_MODEL), 0.01),
        "g_post_ffn": 1.0 + nrm(ks[20], (DEPTH, D_MODEL), 0.01),
        "w_router": nrm(ks[21], (DEPTH, D_MODEL, N_EXPERTS), D_MODEL ** -0.5),
        "b_router": nrm(ks[22], (DEPTH, N_EXPERTS), 0.01),
        "w_e1": nrm(ks[23], (DEPTH, N_EXPERTS, D_MODEL, 2 * D_FF), D_MODEL ** -0.5),
        "b_e1": nrm(ks[24], (DEPTH, N_EXPERTS, 2 * D_FF), 0.01),
        "w_e2": nrm(ks[25], (DEPTH, N_EXPERTS, D_FF, D_MODEL), D_FF ** -0.5),
        "b_e2": nrm(ks[26], (DEPTH, N_EXPERTS, D_MODEL), 0.01),
    }


def reference(x, c, positions, w_ada, b_ada, g_pre_mix, g_post_mix, w_in, b_in, sinks, conv_w, conv_b,
              w_rg, b_rg, w_ig, b_ig, lru_a, w_out, b_out, g_pre_ffn, g_post_ffn, w_router, b_router,
              w_e1, b_e1, w_e2, b_e2):
    B, S, D = x.shape
    for l in range(DEPTH):
        mod = (jax.nn.silu(c) @ w_ada[l] + b_ada[l])[:, None, :]
        sh1, sc1, gt1, sh2, sc2, gt2 = jnp.split(mod, 6, axis=-1)
        h = rms_norm(x, g_pre_mix[l]) * (1.0 + sc1) + sh1
        y = hybrid_mixer(h, positions, w_in[l], b_in[l], sinks[l], conv_w[l], conv_b[l], w_rg[l], b_rg[l],
                         w_ig[l], b_ig[l], lru_a[l], w_out[l], b_out[l])
        x = x + gt1 * rms_norm(y, g_post_mix[l])
        h = rms_norm(x, g_pre_ffn[l]) * (1.0 + sc2) + sh2
        y = moe_ffn(h.reshape(B * S, D), w_router[l], b_router[l], w_e1[l], b_e1[l], w_e2[l], b_e2[l]).reshape(B, S, D)
        x = x + gt2 * rms_norm(y, g_post_ffn[l])
    return x
```

```cpp
#include <hip/hip_runtime.h>
#include <cstdio>
#include <cstdint>

#ifndef MK_N_LAUNCHES
#define MK_N_LAUNCHES 1
#endif

#ifndef FULL_LINE_F8
#define FULL_LINE_F8 true
#endif
#ifndef FULL_LINE_BF16
#define FULL_LINE_BF16 false
#endif
#define LAS __attribute__((address_space(3)))
#define GAS __attribute__((address_space(1)))

namespace pg8 {
#define PG8_LAS __attribute__((address_space(3)))
#define POS_LDS_OFF (131072 + 1024)
#define BIAS_LDS_OFF (131072 + 30720)
typedef unsigned short bf16_t;
typedef short bf16x8 __attribute__((ext_vector_type(8)));
typedef float f32x4 __attribute__((ext_vector_type(4)));
typedef unsigned u32x4 __attribute__((ext_vector_type(4)));
constexpr int BM = 256, BK = 64, HALF = 128, HTB = HALF * BK * 2, STAGE_BYTES = 8 * HTB, NXCD = 8, WGM = 8;

__host__ __device__ __forceinline__ int lds_byte(int r, int c) { const int st = (r >> 4) * 2 + (c >> 5), rr = r & 15, cc = c & 31, ob = rr * 64 + cc * 2; return st * 1024 + (ob ^ (((ob >> 9) & 1) << 5)); }
__host__ __device__ __forceinline__ void stage_rc(int b, int& R, int& C) { const int st = b / 1024, sb = b % 1024, swz = sb ^ (((sb >> 9) & 1) << 5); R = (st >> 1) * 16 + swz / 64; C = (st & 1) * 32 + (swz % 64) / 2; }
__host__ __device__ __forceinline__ int perm32(int rho) { const int n = rho >> 4, i = rho & 15; return 8 * (i >> 2) + 4 * n + (i & 3); }

struct Unit { int pm, pn; };
struct Gemm { const bf16_t* A; const bf16_t* Bt; int K; const PG8_LAS int* etab; size_t estride; };

__device__ __forceinline__ int rfl_s(int v) { int r; asm volatile("v_readfirstlane_b32 %0, %1" : "=s"(r) : "v"(v)); return r; }
__device__ __forceinline__ int ld_i32_agent(const int* p) { return (int)__hip_atomic_load((unsigned*)p, __ATOMIC_RELAXED, __HIP_MEMORY_SCOPE_AGENT); }

struct StaticOrder {
    int nM, nN, nwg, G, c;
    __host__ __device__ void init(int nM_, int nN_, int G_, int c_) { nM = nM_; nN = nN_; nwg = nM * nN; G = G_; c = c_; }
    __host__ __device__ bool next(int i, Unit& u) const {
        const long L = (long)i * G + c; if (L >= nwg) return false;
        int wgid = (int)L; { const int q = nwg / NXCD, r = nwg % NXCD, xcd = wgid % NXCD, off = wgid / NXCD; wgid = (xcd < r ? xcd * (q + 1) : r * (q + 1) + (xcd - r) * q) + off; }
        const int nig = WGM * nN, gid = wgid / nig, fm = gid * WGM, gsz = (nM - fm) < WGM ? (nM - fm) : WGM;
        u.pm = fm + ((wgid % nig) % gsz); u.pn = (wgid % nig) / gsz; return true;
    }
    __device__ __forceinline__ void a_ready(const Unit&) const {}
    __device__ __forceinline__ void done(const Unit&) const {}
};

struct TableOrder {
    const PG8_LAS int* tab;
    __device__ __forceinline__ bool next(int i, Unit& u) const { const int v = rfl_s(tab[i]); if (v < 0) return false; u.pm = v & 0xFFFF; u.pn = v >> 16; return true; }
    __device__ __forceinline__ void a_ready(const Unit&) const {}
    __device__ __forceinline__ void done(const Unit&) const {}
};

__device__ __forceinline__ unsigned cvt_pk_bf16(float lo, float hi) { unsigned r; asm volatile("v_cvt_pk_bf16_f32 %0, %1, %2" : "=v"(r) : "v"(lo), "v"(hi)); return r; }

__device__ __forceinline__ float sigm(float x) { return __builtin_amdgcn_rcpf(1.0f + __builtin_amdgcn_exp2f(-1.4426950408889634f * x)); }
__device__ __forceinline__ float gelu_tanh(float x) { const float u = -2.3022082114692686f * (x + 0.044715f * x * x * x); return x * __builtin_amdgcn_rcpf(1.0f + __builtin_amdgcn_exp2f(u)); }

__device__ __forceinline__ float gelu_sigm(float x, float g) {
    const float u = -2.3022082114692686f * (x + 0.044715f * x * x * x);
    return x * __builtin_amdgcn_rcpf((1.0f + __builtin_amdgcn_exp2f(u)) * (1.0f + __builtin_amdgcn_exp2f(-1.4426950408889634f * g))); }

constexpr int IN_W = 5632;
constexpr float QSCALE = 0.125f * 1.4426950408889634f;
struct EpiIn {
    static constexpr bool PERM = true, AFTER_DRAIN = false;
    static constexpr bool NEED_POS = true;
    bf16_t* O; const float* bias; const int* pos;
    __device__ __forceinline__ const float* bias_seg(const Unit& u, int) const { return bias + u.pn * BM; }
    __device__ __forceinline__ void operator()(const f32x4 (&acc)[2][2][4][2], const Unit& u, int wr, int wc, int fr, int fq, const PG8_LAS float* lb, const PG8_LAS int* lp) const {
        const int row0 = u.pm * BM + wr * 64 + fr; const int col0 = u.pn * BM + wc * 32 + 8 * fq;
        const int kind = u.pn <= 4 ? 0 : (u.pn <= 9 ? 1 : ((u.pn <= 13 || u.pn >= 18) ? 4 : 3));
        if (kind == 4) {
            const int j = u.pn <= 13 ? u.pn - 10 : u.pn - 14; const int cin = wc * 32 + 8 * fq;
            f32x4 b0[2], b1[2];
#pragma unroll
            for (int n = 0; n < 2; ++n) { b0[n] = *(const PG8_LAS f32x4*)(lb + 8 * fq + 4 * n); b1[n] = *(const PG8_LAS f32x4*)(lb + 32 + 8 * fq + 4 * n); }
#pragma unroll
            for (int ai = 0; ai < 2; ++ai)
#pragma unroll
                for (int m = 0; m < 4; ++m) { bf16_t* rowp = O + (size_t)(row0 + ai * HALF + m * 16) * IN_W + 2560 + j * HALF + cin;
                    f32x4 o[2];
#pragma unroll
                    for (int n = 0; n < 2; ++n) { const f32x4 ly = acc[ai][0][m][n] + b0[n], gl = acc[ai][1][m][n] + b1[n];
#pragma unroll
                        for (int e = 0; e < 4; ++e) o[n][e] = gelu_sigm(ly[e], gl[e]); }
                    u32x4 w; w.x = cvt_pk_bf16(o[0][0], o[0][1]); w.y = cvt_pk_bf16(o[0][2], o[0][3]); w.z = cvt_pk_bf16(o[1][0], o[1][1]); w.w = cvt_pk_bf16(o[1][2], o[1][3]);
                    *(u32x4*)rowp = w; }
            return;
        }
        const float qs = u.pn < 4 ? QSCALE : 1.0f;
        const int i0 = 16 * (wc & 1) + 4 * fq;
        float cf[4];
#pragma unroll
        for (int j = 0; j < 4; ++j) cf[j] = kind == 0 ? exp2f(-(float)(2 * (i0 + j)) * (13.287712379549449f / 64.0f)) * 0.15915494309189535f : 0.0f;
        f32x4 bv[2][2];
#pragma unroll
        for (int bj = 0; bj < 2; ++bj)
#pragma unroll
            for (int n = 0; n < 2; ++n) bv[bj][n] = *(const PG8_LAS f32x4*)(lb + bj * 32 + 8 * fq + 4 * n);
#pragma unroll
        for (int ai = 0; ai < 2; ++ai)
#pragma unroll
            for (int m = 0; m < 4; ++m) { const int row = row0 + ai * HALF + m * 16; bf16_t* rowp = O + (size_t)row * IN_W + col0;
                f32x4 c0 = {1.f, 0.f, 1.f, 0.f}, c1 = {1.f, 0.f, 1.f, 0.f};
                if (kind == 0) { const float pf = (float)lp[ai * 64 + m * 16 + fr]; float cc[4], sn[4];
#pragma unroll
                    for (int j = 0; j < 4; ++j) { const float hi = pf * cf[j]; const float fr_ = (hi - __builtin_rintf(hi)) + __builtin_fmaf(pf, cf[j], -hi); cc[j] = __builtin_amdgcn_cosf(fr_); sn[j] = __builtin_amdgcn_sinf(fr_); }
                    c0 = (f32x4){cc[0], sn[0], cc[1], sn[1]}; c1 = (f32x4){cc[2], sn[2], cc[3], sn[3]}; }
#pragma unroll
                for (int bj = 0; bj < 2; ++bj) { f32x4 v0 = acc[ai][bj][m][0] + bv[bj][0], v1 = acc[ai][bj][m][1] + bv[bj][1];
                    if (kind == 0) {
                        f32x4 o0, o1;
                        o0[0] = v0[0] * c0[0] - v0[1] * c0[1]; o0[1] = v0[1] * c0[0] + v0[0] * c0[1];
                        o0[2] = v0[2] * c0[2] - v0[3] * c0[3]; o0[3] = v0[3] * c0[2] + v0[2] * c0[3];
                        o1[0] = v1[0] * c1[0] - v1[1] * c1[1]; o1[1] = v1[1] * c1[0] + v1[0] * c1[1];
                        o1[2] = v1[2] * c1[2] - v1[3] * c1[3]; o1[3] = v1[3] * c1[2] + v1[2] * c1[3];
                        v0 = o0 * qs; v1 = o1 * qs;
                    } else if (kind == 2) {
#pragma unroll
                        for (int e = 0; e < 4; ++e) { v0[e] = gelu_tanh(v0[e]); v1[e] = gelu_tanh(v1[e]); }
                    } else if (kind == 3) {
#pragma unroll
                        for (int e = 0; e < 4; ++e) { v0[e] = sigm(v0[e]); v1[e] = sigm(v1[e]); }
                    }
                    u32x4 w; w.x = cvt_pk_bf16(v0[0], v0[1]); w.y = cvt_pk_bf16(v0[2], v0[3]); w.z = cvt_pk_bf16(v1[0], v1[1]); w.w = cvt_pk_bf16(v1[2], v1[3]);
                    *(u32x4*)(rowp + bj * HALF) = w; } }
    }
};
struct EpiF32 {
    static constexpr bool NEED_POS = false;
    static constexpr bool PERM = false, AFTER_DRAIN = false;
    float* O; int ldc; const float* bias;
    __device__ __forceinline__ const float* bias_seg(const Unit& u, int) const { return bias + u.pn * BM; }
    __device__ __forceinline__ void operator()(const f32x4 (&acc)[2][2][4][2], const Unit& u, int wr, int wc, int fr, int fq, const PG8_LAS float*, const PG8_LAS int*) const {
        const int col0 = u.pn * BM + wc * 32 + 4 * fq;
        f32x4 bv[2][2];
#pragma unroll
        for (int bj = 0; bj < 2; ++bj)
#pragma unroll
            for (int n = 0; n < 2; ++n) bv[bj][n] = *(const f32x4*)(bias + col0 + bj * HALF + n * 16);
#pragma unroll
        for (int ai = 0; ai < 2; ++ai)
#pragma unroll
            for (int m = 0; m < 4; ++m) { const int r = ai * HALF + wr * 64 + m * 16 + fr; const size_t off = (size_t)(u.pm * BM + r) * ldc + col0;
#pragma unroll
                for (int bj = 0; bj < 2; ++bj)
#pragma unroll
                    for (int n = 0; n < 2; ++n) *(f32x4*)(O + off + bj * HALF + n * 16) = acc[ai][bj][m][n] + bv[bj][n]; }
    }
};
struct EpiBf16 {
    static constexpr bool NEED_POS = false;
    static constexpr bool PERM = true, AFTER_DRAIN = false;
    bf16_t* O; int ldc; const float* bias;
    __device__ __forceinline__ const float* bias_seg(const Unit& u, int) const { return bias + u.pn * BM; }
    __device__ __forceinline__ void operator()(const f32x4 (&acc)[2][2][4][2], const Unit& u, int wr, int wc, int fr, int fq, const PG8_LAS float* lb, const PG8_LAS int*) const {
        const int row0 = u.pm * BM + wr * 64 + fr; const int col0 = u.pn * BM + wc * 32 + 8 * fq;
        f32x4 bv[2][2];
#pragma unroll
        for (int bj = 0; bj < 2; ++bj)
#pragma unroll
            for (int n = 0; n < 2; ++n) bv[bj][n] = *(const PG8_LAS f32x4*)(lb + bj * 32 + 8 * fq + 4 * n);
#pragma unroll
        for (int ai = 0; ai < 2; ++ai)
#pragma unroll
            for (int m = 0; m < 4; ++m) { bf16_t* rowp = O + (size_t)(row0 + ai * HALF + m * 16) * ldc + col0;
#pragma unroll
                for (int bj = 0; bj < 2; ++bj) { const f32x4 v0 = acc[ai][bj][m][0] + bv[bj][0], v1 = acc[ai][bj][m][1] + bv[bj][1];
                    u32x4 w; w.x = cvt_pk_bf16(v0[0], v0[1]); w.y = cvt_pk_bf16(v0[2], v0[3]); w.z = cvt_pk_bf16(v1[0], v1[1]); w.w = cvt_pk_bf16(v1[2], v1[3]);
                    *(u32x4*)(rowp + bj * HALF) = w; } }
    }
};
__device__ __forceinline__ unsigned pk4_fp8(float a, float b, float c, float d) {
    a = __builtin_amdgcn_fmed3f(a, -448.f, 448.f); b = __builtin_amdgcn_fmed3f(b, -448.f, 448.f); c = __builtin_amdgcn_fmed3f(c, -448.f, 448.f); d = __builtin_amdgcn_fmed3f(d, -448.f, 448.f);
    int p = 0; p = __builtin_amdgcn_cvt_pk_fp8_f32(a, b, p, false); p = __builtin_amdgcn_cvt_pk_fp8_f32(c, d, p, true); return (unsigned)p;
}
__device__ __forceinline__ unsigned pk4_fp8_nc(float a, float b, float c, float d) {
    int p = 0; p = __builtin_amdgcn_cvt_pk_fp8_f32(a, b, p, false); p = __builtin_amdgcn_cvt_pk_fp8_f32(c, d, p, true); return (unsigned)p;
}
constexpr float W8_SCALE = 32.0f, W8_INV = 1.0f / 32.0f;
struct EpiSwiglu8 {
    static constexpr bool NEED_POS = false;
    static constexpr bool PERM = true, AFTER_DRAIN = false;
    unsigned char* O; const float* bias  ; const PG8_LAS int* etab;
    __device__ __forceinline__ const float* bias_seg(const Unit& u, int ui) const { return bias + ((unsigned)rfl_s(etab[ui]) * 2048u + (unsigned)(u.pn * BM)); }
    __device__ __forceinline__ void operator()(const f32x4 (&acc)[2][2][4][2], const Unit& u, int wr, int wc, int fr, int fq, const PG8_LAS float* lb, const PG8_LAS int*) const {
        const int row0 = u.pm * BM + wr * 64 + fr; const int cin = wc * 32 + 8 * fq;
        f32x4 bv[2][2];
#pragma unroll
        for (int bj = 0; bj < 2; ++bj)
#pragma unroll
            for (int n = 0; n < 2; ++n) bv[bj][n] = *(const PG8_LAS f32x4*)(lb + bj * 32 + 8 * fq + 4 * n) + (bj ? 1.0f : 0.0f);
#pragma unroll
        for (int ai = 0; ai < 2; ++ai)
#pragma unroll
            for (int m = 0; m < 4; ++m) { unsigned char* rowp = O + (size_t)(row0 + ai * HALF + m * 16) * 1024 + u.pn * HALF + cin;
                f32x4 o[2];
#pragma unroll
                for (int n = 0; n < 2; ++n) { const f32x4 g = acc[ai][0][m][n] * W8_INV + bv[0][n], uu = acc[ai][1][m][n] * W8_INV + bv[1][n];
#pragma unroll
                    for (int q = 0; q < 4; ++q) { const float gc = fminf(g[q], 7.0f), uc1 = __builtin_amdgcn_fmed3f(uu[q], -6.0f, 8.0f);
                        o[n][q] = gc * uc1 * __builtin_amdgcn_rcpf(1.0f + __builtin_amdgcn_exp2f(-1.702f * 1.4426950408889634f * gc)); } }
                typedef unsigned u32x2 __attribute__((ext_vector_type(2)));
                u32x2 w; w.x = pk4_fp8_nc(o[0][0], o[0][1], o[0][2], o[0][3]); w.y = pk4_fp8_nc(o[1][0], o[1][1], o[1][2], o[1][3]);
                *(u32x2*)rowp = w; }
    }
};
struct EpiExpOut8 {
    static constexpr bool NEED_POS = false;
    static constexpr bool PERM = true, AFTER_DRAIN = false;
    unsigned char* O; const float* bias  ; const PG8_LAS int* etab;
    __device__ __forceinline__ const float* bias_seg(const Unit& u, int ui) const { return bias + ((unsigned)rfl_s(etab[ui]) * 1024u + (unsigned)(u.pn * BM)); }
    __device__ __forceinline__ void operator()(const f32x4 (&acc)[2][2][4][2], const Unit& u, int wr, int wc, int fr, int fq, const PG8_LAS float* lb, const PG8_LAS int*) const {
        const int row0 = u.pm * BM + wr * 64 + fr; const int col0 = u.pn * BM + wc * 32 + 8 * fq;
        f32x4 bv[2][2];
#pragma unroll
        for (int bj = 0; bj < 2; ++bj)
#pragma unroll
            for (int n = 0; n < 2; ++n) bv[bj][n] = *(const PG8_LAS f32x4*)(lb + bj * 32 + 8 * fq + 4 * n);
        typedef unsigned u32x2 __attribute__((ext_vector_type(2)));
#pragma unroll
        for (int ai = 0; ai < 2; ++ai)
#pragma unroll
            for (int m = 0; m < 4; ++m) { unsigned char* rowp = O + (size_t)(row0 + ai * HALF + m * 16) * 1024 + col0;
#pragma unroll
                for (int bj = 0; bj < 2; ++bj) { const f32x4 v0 = acc[ai][bj][m][0] * W8_INV + bv[bj][0], v1 = acc[ai][bj][m][1] * W8_INV + bv[bj][1];
                    u32x2 w; w.x = pk4_fp8(v0[0], v0[1], v0[2], v0[3]); w.y = pk4_fp8(v1[0], v1[1], v1[2], v1[3]);
                    *(u32x2*)(rowp + bj * HALF) = w; } }
    }
};

__device__ __forceinline__ void glds16(const char* gbase  , unsigned voff, unsigned m0v  ) {
    unsigned keep;
    asm volatile("s_mov_b32 %0, m0\n\ts_mov_b32 m0, %2\n\ts_nop 0\n\tglobal_load_lds_dwordx4 %1, %3\n\ts_mov_b32 m0, %0"
                 : "=&s"(keep) : "v"(voff), "s"(m0v), "s"(gbase) : "memory");
}
__device__ __forceinline__ void glds4(const char* gbase  , unsigned voff, unsigned m0v  ) {
    unsigned keep;
    asm volatile("s_mov_b32 %0, m0\n\ts_mov_b32 m0, %2\n\ts_nop 0\n\tglobal_load_lds_dword %1, %3\n\ts_mov_b32 m0, %0"
                 : "=&s"(keep) : "v"(voff), "s"(m0v), "s"(gbase) : "memory");
}
__device__ __forceinline__ const char* b_tile_ptr(const Gemm& g, const Unit& u, size_t tstep, int ui) {
    const char* p = (const char*)g.Bt + (size_t)u.pn * tstep;
    if (g.etab) p += (size_t)((unsigned)rfl_s(g.etab[ui]) * (unsigned)g.estride);
    return p;
}

typedef int i32x4 __attribute__((ext_vector_type(4)));
typedef int i32x8 __attribute__((ext_vector_type(8)));
template <class Epi, class Sched, bool ALIGN_EPI = false, bool SP2 = false, bool F8 = false, bool GATHER = false, bool PF = false>
__device__ __forceinline__ void gemm_phase(PG8_LAS unsigned char* lds, const Gemm g, const Sched& S, const Epi& E, const PG8_LAS unsigned short* rtab = nullptr) {
    int tid_ = threadIdx.x; asm volatile("" : "+v"(tid_));
    const int tid = tid_, wid = __builtin_amdgcn_readfirstlane(tid >> 6), lane = tid & 63, wr = wid >> 2, wc = wid & 3, fr = lane & 15, fq = lane >> 4;
    const int K = g.K, KB = F8 ? K : 2 * K, nt = KB / 128;
    constexpr bool FL = FULL_LINE_F8 ? (F8 || FULL_LINE_BF16) : false;
#define PG8_FSW(r15) ((((r15) >> 1) & 7) ^ (((((r15) + 4) >> 3) & 1) * (F8 ? 2 : 1)))
    unsigned voffA[2], voffB[2];
#pragma unroll
    for (int i = 0; i < 2; ++i) {
        if constexpr (FL) { const int q = tid + 512 * i, R = 8 * (q >> 6) + ((q >> 3) & 7), Cb = 16 * ((q & 7) ^ PG8_FSW(R & 15)); const int Rb = Epi::PERM ? ((R & ~31) + perm32(R & 31)) : R;
            voffA[i] = (unsigned)(R * KB + Cb); voffB[i] = (unsigned)(Rb * KB + Cb); }
        else if constexpr (F8) { const int q = tid + 512 * i, R = 16 * (q >> 7) + (q & 15), Cb = 16 * ((q >> 4) & 7); const int Rb = Epi::PERM ? ((R & ~31) + perm32(R & 31)) : R;
            voffA[i] = (unsigned)(R * KB + Cb); voffB[i] = (unsigned)(Rb * KB + Cb); }
        else { int R, C; stage_rc(tid * 16 + i * 8192, R, C); const int Rb = Epi::PERM ? ((R & ~31) + perm32(R & 31)) : R;
            voffA[i] = (unsigned)(R * K + C) * 2u; voffB[i] = (unsigned)(Rb * K + C) * 2u; } }
    const size_t kstep = (size_t)128;
    const size_t hstep = (size_t)HALF * KB;
    const size_t tstep = 2 * hstep;
    const unsigned ldsw = (unsigned)wid * 1024u;
    int aoffk[2], boffk[2];
#pragma unroll
    for (int k = 0; k < 2; ++k) {
        if constexpr (FL) { const int cs = F8 ? 2 * fq + k : fq + 4 * k, c = cs ^ PG8_FSW(fr); aoffk[k] = (wr * 64 + fr) * 128 + c * 16; boffk[k] = (wc * 32 + fr) * 128 + c * 16; }
        else if constexpr (F8) { aoffk[k] = (wr * 4) * 2048 + (2 * fq + k) * 256 + fr * 16; boffk[k] = (wc * 2) * 2048 + (2 * fq + k) * 256 + fr * 16; }
        else { aoffk[k] = lds_byte(wr * 64 + fr, fq * 8) + k * 1024; boffk[k] = lds_byte(wc * 32 + fr, fq * 8) + k * 1024; } }
    const int sc1 = 0x7F7F7F7F;
    unsigned cG0[2] = {0u, 0u}, cG1[2] = {0u, 0u};
    int nui = 0;
#define PG8_GOFS1(ui_, h, o) do { _Pragma("unroll") for (int _i = 0; _i < 2; ++_i) { int R_, Cb_; \
        if constexpr (FL) { const int q_ = tid + 512 * _i; R_ = 8 * (q_ >> 6) + ((q_ >> 3) & 7); Cb_ = 16 * ((q_ & 7) ^ PG8_FSW(R_ & 15)); } \
        else if constexpr (F8) { const int q_ = tid + 512 * _i; R_ = 16 * (q_ >> 7) + (q_ & 15); Cb_ = 16 * ((q_ >> 4) & 7); } else { int C_; stage_rc(tid * 16 + _i * 8192, R_, C_); Cb_ = 2 * C_; } \
        (o)[_i] = (unsigned)rtab[(ui_) * 256 + (h) * 128 + R_] * (unsigned)KB + (unsigned)Cb_; } } while (0)
#define PG8_STAGE_A(bufoff, gbase, h, nx) do { if constexpr (GATHER) { if (nx) { unsigned vo_[2]; PG8_GOFS1(nui, h, vo_); PG8_STAGE(bufoff, gbase, vo_); } else { if (h) PG8_STAGE(bufoff, gbase, cG1); else PG8_STAGE(bufoff, gbase, cG0); } } \
        else { PG8_STAGE(bufoff, (gbase) + (h) * hstep, voffA); } } while (0)
    unsigned pfd = 0u; const unsigned pfoff = (unsigned)((tid & 255) * KB);
    const char* nA = nullptr; const char* nB = nullptr;
#define PG8_PF(tt_) do { if constexpr (PF) { const int tt__ = (tt_); const bool nx__ = tt__ >= nt; const int tk__ = nx__ ? tt__ - nt : tt__; \
        const char* pb__ = (wid < 4) ? ((nx__ ? nA : cA) + (size_t)tk__ * kstep) : ((nx__ ? nB : cB) + (size_t)tk__ * kstep); unsigned vo__ = pfoff; \
        if constexpr (GATHER) { if (wid < 4) vo__ = (unsigned)rtab[(nx__ ? nui : ui) * 256 + tid] * (unsigned)KB; } \
        asm volatile("global_load_dword %0, %1, %2" : "+v"(pfd) : "v"(vo__), "s"(pb__) : "memory"); } } while (0)
#define PG8_SA(b, h) (((b) * 2 + (h)) * HTB)
#define PG8_SB(b, h) ((4 + (b) * 2 + (h)) * HTB)
    const unsigned ldsbase = (unsigned)__builtin_amdgcn_readfirstlane((int)((unsigned)(size_t)lds + ldsw));
#define PG8_STAGE(bufoff, gbase, voff) do { _Pragma("unroll") for (int _i = 0; _i < 2; ++_i) glds16((const char*)(gbase), (voff)[_i], ldsbase + (unsigned)((bufoff) + _i * 8192)); } while (0)
#define PG8_LDA(dst, b, h) do { _Pragma("unroll") for (int m = 0; m < 4; ++m) _Pragma("unroll") for (int k = 0; k < 2; ++k) dst[m][k] = *(const PG8_LAS bf16x8*)(lds + PG8_SA(b, h) + aoffk[k] + m * 2048); } while (0)
#define PG8_LDB(dst, b, h) do { _Pragma("unroll") for (int n = 0; n < 2; ++n) _Pragma("unroll") for (int k = 0; k < 2; ++k) dst[n][k] = *(const PG8_LAS bf16x8*)(lds + PG8_SB(b, h) + boffk[k] + n * 2048); } while (0)
#define PG8_CAT(v) __builtin_shufflevector(__builtin_bit_cast(i32x4, (v)[0]), __builtin_bit_cast(i32x4, (v)[1]), 0, 1, 2, 3, 4, 5, 6, 7)
#define PG8_MMA(ai, bj, At, Bt) do { __builtin_amdgcn_s_setprio(1); if constexpr (F8) { _Pragma("unroll") for (int m = 0; m < 4; ++m) _Pragma("unroll") for (int n = 0; n < 2; ++n) { \
        const i32x8 a8_ = PG8_CAT(Bt[n]), b8_ = PG8_CAT(At[m]); asm volatile("v_mfma_scale_f32_16x16x128_f8f6f4 %0, %1, %2, %0, %3, %3 op_sel_hi:[0,0,0]" : "+v"(acc[ai][bj][m][n]) : "v"(a8_), "v"(b8_), "v"(sc1)); } } \
        else { _Pragma("unroll") for (int m = 0; m < 4; ++m) _Pragma("unroll") for (int n = 0; n < 2; ++n) _Pragma("unroll") for (int k = 0; k < 2; ++k) \
        acc[ai][bj][m][n] = __builtin_amdgcn_mfma_f32_16x16x32_bf16(Bt[n][k], At[m][k], acc[ai][bj][m][n], 0, 0, 0); } __builtin_amdgcn_s_setprio(0); } while (0)
#define PG8_WAIT_V(n) asm volatile("s_waitcnt vmcnt(" #n ")" ::: "memory")
#define PG8_WAIT_L(n) asm volatile("s_waitcnt lgkmcnt(" #n ")" ::: "memory")
#define PG8_BAR __builtin_amdgcn_s_barrier()
#define PG8_SCHED __builtin_amdgcn_sched_barrier(0)
    const unsigned lbias = (unsigned)__builtin_amdgcn_readfirstlane((int)((unsigned)(size_t)lds + (unsigned)BIAS_LDS_OFF + (unsigned)wid * 256u));
    const PG8_LAS float* lb = (const PG8_LAS float*)(lds + BIAS_LDS_OFF + wid * 256);
    const unsigned voffbias = (unsigned)(((lane >> 5) * HALF + wc * 32 + (lane & 31)) * 4);
    const unsigned lposa = (unsigned)__builtin_amdgcn_readfirstlane((int)((unsigned)(size_t)lds + (unsigned)POS_LDS_OFF + (unsigned)wid * 512u));
    const PG8_LAS int* lp = (const PG8_LAS int*)(lds + POS_LDS_OFF + wid * 512);
#define PG8_UNIT_DMA(u_, ui_) do { glds4((const char*)E.bias_seg(u_, ui_), voffbias, lbias); \
        if constexpr (Epi::NEED_POS) { const char* pp_ = (const char*)(E.pos + (u_).pm * BM + wr * 64); glds4(pp_, (unsigned)lane * 4u, lposa); glds4(pp_ + 512, (unsigned)lane * 4u, lposa + 256u); } } while (0)
    Unit cur, nxt; int ui = 0;
    if (!S.next(0, cur)) return;
    PG8_UNIT_DMA(cur, 0);
    f32x4 acc[2][2][4][2];
#pragma unroll
    for (int a = 0; a < 2; ++a)
#pragma unroll
        for (int b = 0; b < 2; ++b)
#pragma unroll
            for (int m = 0; m < 4; ++m)
#pragma unroll
                for (int n = 0; n < 2; ++n) acc[a][b][m][n] = (f32x4){0.f, 0.f, 0.f, 0.f};
    bf16x8 At[4][2], B0[2][2], B1[2][2];
    const char* cA = GATHER ? (const char*)g.A : (const char*)g.A + (size_t)cur.pm * tstep; const char* cB = b_tile_ptr(g, cur, tstep, 0);
    if constexpr (GATHER) { PG8_GOFS1(0, 0, cG0); PG8_GOFS1(0, 1, cG1); }
    S.a_ready(cur);
    if constexpr (SP2) {
        PG8_STAGE(PG8_SB(0, 0), cB, voffB); PG8_STAGE(PG8_SB(0, 1), cB + hstep, voffB); PG8_STAGE_A(PG8_SA(0, 0), cA, 0, false); PG8_STAGE_A(PG8_SA(0, 1), cA, 1, false);
        if (wr == 1) PG8_BAR;
        PG8_WAIT_V(2); PG8_BAR;
        PG8_STAGE(PG8_SB(1, 0), cB + kstep, voffB); PG8_STAGE_A(PG8_SA(1, 0), cA + kstep, 0, false); PG8_STAGE(PG8_SB(1, 1), cB + hstep + kstep, voffB);
        PG8_WAIT_V(6); PG8_BAR;
        if constexpr (PF) { nA = cA; nB = cB; PG8_PF(2); }
    } else {
        PG8_STAGE(PG8_SB(0, 0), cB, voffB); PG8_STAGE(PG8_SA(0, 0), cA, voffA); PG8_STAGE(PG8_SB(0, 1), cB + hstep, voffB); PG8_STAGE(PG8_SA(0, 1), cA + hstep, voffA);
        if (wr == 1) PG8_BAR;
        PG8_WAIT_V(4); PG8_BAR;
        PG8_STAGE(PG8_SB(1, 0), cB + kstep, voffB); PG8_STAGE(PG8_SA(1, 0), cA + kstep, voffA); PG8_STAGE(PG8_SB(1, 1), cB + hstep + kstep, voffB);
        PG8_WAIT_V(6); PG8_BAR;
    }
    for (;;) {
        const bool has_next = S.next(ui + 1, nxt);
        nA = GATHER ? cA : (has_next ? (const char*)g.A + (size_t)nxt.pm * tstep : cA); nB = has_next ? b_tile_ptr(g, nxt, tstep, ui + 1) : cB;
        if constexpr (GATHER) nui = has_next ? ui + 1 : ui;
#pragma unroll 1
        for (int t = 0; t < nt; t += 2) {
            const bool last = (t == nt - 2);
            const char* a1 = cA + (size_t)(t + 1) * kstep;
            const char* a2 = last ? nA : cA + (size_t)(t + 2) * kstep; const char* b2 = last ? nB : cB + (size_t)(t + 2) * kstep;
            const char* a3 = a2 + kstep; const char* b3 = b2 + kstep;
            if (last && has_next) S.a_ready(nxt);
            if constexpr (SP2) {
            PG8_LDB(B0, 0, 0); PG8_LDB(B1, 0, 1); PG8_SCHED; PG8_LDA(At, 0, 0); PG8_STAGE_A(PG8_SA(1, 1), a1, 1, false);
            if constexpr (PF) PG8_WAIT_V(9); else PG8_WAIT_V(8);
            PG8_WAIT_L(0); PG8_BAR; PG8_MMA(0, 0, At, B0); PG8_MMA(0, 1, At, B1); PG8_BAR; PG8_SCHED;
            PG8_LDA(At, 0, 1); PG8_STAGE(PG8_SB(0, 0), b2, voffB); PG8_STAGE(PG8_SB(0, 1), b2 + hstep, voffB); PG8_STAGE_A(PG8_SA(0, 0), a2, 0, last); PG8_PF(t + 4);
            if constexpr (PF) PG8_WAIT_V(10); else PG8_WAIT_V(8);
            PG8_WAIT_L(0); PG8_BAR; PG8_MMA(1, 0, At, B0); PG8_MMA(1, 1, At, B1); PG8_BAR; PG8_SCHED;
            PG8_LDB(B0, 1, 0); PG8_LDB(B1, 1, 1); PG8_SCHED; PG8_LDA(At, 1, 0); PG8_STAGE_A(PG8_SA(0, 1), a2, 1, last);
            if constexpr (PF) PG8_WAIT_V(9); else PG8_WAIT_V(8);
            PG8_WAIT_L(0); PG8_BAR; PG8_MMA(0, 0, At, B0); PG8_MMA(0, 1, At, B1); PG8_BAR; PG8_SCHED;
            PG8_LDA(At, 1, 1); PG8_STAGE(PG8_SB(1, 0), b3, voffB); PG8_STAGE(PG8_SB(1, 1), b3 + hstep, voffB); PG8_STAGE_A(PG8_SA(1, 0), a3, 0, last); PG8_PF(t + 5);
            if constexpr (PF) PG8_WAIT_V(10); else PG8_WAIT_V(8);
            PG8_WAIT_L(0); PG8_BAR; PG8_MMA(1, 0, At, B0); PG8_MMA(1, 1, At, B1); PG8_BAR; PG8_SCHED;
            } else {
            static_assert(SP2 || !GATHER, "GATHER is implemented for the SP2 loop only");
            PG8_LDB(B0, 0, 0); PG8_SCHED; PG8_LDA(At, 0, 0); PG8_STAGE(PG8_SA(1, 1), a1 + hstep, voffA);
            PG8_WAIT_L(8); PG8_BAR; PG8_WAIT_L(0); PG8_MMA(0, 0, At, B0); PG8_BAR; PG8_SCHED;
            PG8_LDB(B1, 0, 1); PG8_STAGE(PG8_SB(0, 0), b2, voffB);
            PG8_BAR; PG8_WAIT_L(0); PG8_MMA(0, 1, At, B1); PG8_BAR;
            PG8_LDA(At, 0, 1); PG8_STAGE(PG8_SA(0, 0), a2, voffA);
            PG8_BAR; PG8_WAIT_L(0); PG8_MMA(1, 0, At, B0); PG8_BAR; PG8_SCHED;
            PG8_STAGE(PG8_SB(0, 1), b2 + hstep, voffB);
            PG8_WAIT_V(6); PG8_BAR; PG8_MMA(1, 1, At, B1); PG8_BAR;
            PG8_LDB(B0, 1, 0); PG8_SCHED; PG8_LDA(At, 1, 0); PG8_STAGE(PG8_SA(0, 1), a2 + hstep, voffA);
            PG8_WAIT_L(8); PG8_BAR; PG8_WAIT_L(0); PG8_MMA(0, 0, At, B0); PG8_BAR; PG8_SCHED;
            PG8_LDB(B1, 1, 1); PG8_STAGE(PG8_SB(1, 0), b3, voffB);
            PG8_BAR; PG8_WAIT_L(0); PG8_MMA(0, 1, At, B1); PG8_BAR;
            PG8_LDA(At, 1, 1); PG8_STAGE(PG8_SA(1, 0), a3, voffA);
            PG8_BAR; PG8_WAIT_L(0); PG8_MMA(1, 0, At, B0); PG8_BAR; PG8_SCHED;
            PG8_STAGE(PG8_SB(1, 1), b3 + hstep, voffB);
            PG8_WAIT_V(6); PG8_BAR; PG8_MMA(1, 1, At, B1); PG8_BAR;
            }
        }
        if constexpr (ALIGN_EPI) { if (wr == 0) PG8_BAR; }
        if constexpr (F8) asm volatile("s_nop 15\n\ts_nop 15" ::: "memory");
        if constexpr (!Epi::AFTER_DRAIN) { E(acc, cur, wr, wc, fr, fq, lb, lp); S.done(cur); }
        if (!has_next) break;
#pragma unroll
        for (int a = 0; a < 2; ++a)
#pragma unroll
            for (int b = 0; b < 2; ++b)
#pragma unroll
                for (int m = 0; m < 4; ++m)
#pragma unroll
                    for (int n = 0; n < 2; ++n) acc[a][b][m][n] = (f32x4){0.f, 0.f, 0.f, 0.f};
        cur = nxt; cA = nA; cB = nB; ++ui;
        asm volatile("s_waitcnt lgkmcnt(0)" ::: "memory");
        PG8_UNIT_DMA(cur, ui);
        if constexpr (GATHER) { PG8_GOFS1(ui, 0, cG0); PG8_GOFS1(ui, 1, cG1); }
        if constexpr (ALIGN_EPI) { if (wr == 1) PG8_BAR; }
    }
    PG8_WAIT_V(0);
    asm volatile("" :: "v"(pfd));
    if constexpr (!ALIGN_EPI) { if (wr == 0) PG8_BAR; }
    PG8_BAR;
#undef PG8_UNIT_DMA
#undef PG8_SA
#undef PG8_SB
#undef PG8_FSW
#undef PG8_PF
#undef PG8_STAGE_A
#undef PG8_GOFS1
#undef PG8_STAGE
#undef PG8_LDA
#undef PG8_LDB
#undef PG8_MMA
#undef PG8_CAT
#undef PG8_WAIT_V
#undef PG8_WAIT_L
#undef PG8_BAR
#undef PG8_SCHED
}
}

constexpr int BATCH = 32, SEQ = 2048, D = 1024, T = BATCH * SEQ;
constexpr int INW = 5632, NE = 32, NHQ = 16, HD = 64;
constexpr int C_K = 1024, C_V = 1280, C_LX = 1536, C_LY = 2560, C_GA = 3584, C_GL = 4608;
constexpr float EPS = 1e-6f, LOG2E = 1.4426950408889634f;
constexpr int HALF_T = T / 2, NGRP = T / 256, GRP_H = NGRP / 2;
constexpr int MAXBLK = T * 4 / 256 + NE;

constexpr size_t MiB = 1u << 20;
constexpr size_t WS_CTL = 0, CTL_ZERO_BYTES = 1 * MiB;
constexpr size_t WS_MOD = 1 * MiB;
constexpr size_t WS_BINP = 2 * MiB, WS_LC = 2 * MiB + 32768, WS_WRT = 2 * MiB + 65536, WS_BE1P = 2 * MiB + 262144;
constexpr size_t WS_WRGT = 3 * MiB, WS_WIGT = 3 * MiB + 262144;
constexpr size_t WS_CNT = 4 * MiB, WS_NBLK = 4 * MiB + 65536, WS_BLKE = 4 * MiB + 131072;
constexpr size_t WS_TKI = 5 * MiB, WS_TKW = 6 * MiB, WS_TKP = 7 * MiB, WS_SLOT = 8 * MiB;
constexpr size_t WS_LP = 10 * MiB, WS_LH = 12 * MiB;
constexpr size_t WS_ROWTOK = 14 * MiB;
constexpr size_t WS_CS = 16 * MiB;
constexpr size_t WS_WBIN = 32 * MiB, WS_WBOUT = 44 * MiB;
constexpr size_t WS_H = 48 * MiB;
constexpr size_t WS_PROJ = 176 * MiB;
constexpr size_t WS_MRG = 880 * MiB;
constexpr size_t WS_Y1 = 600 * MiB;
constexpr size_t WS_WBE1 = 112 * MiB, WS_WBE2 = 176 * MiB;
constexpr size_t WS_ACT = 208 * MiB;
constexpr size_t WS_YP = 472 * MiB, WS_END = 1000 * MiB;
static_assert(WS_PROJ + (size_t)T * INW * 2 <= 1024 * MiB, "proj fits");
static_assert(WS_H + (size_t)T * D <= WS_WBE1 && WS_WBE1 + (size_t)NE * 2048 * D <= WS_WBE2 && WS_WBE2 + (size_t)NE * D * D <= WS_ACT && WS_ACT + (size_t)MAXBLK * 256 * 1024 <= WS_YP && WS_YP + (size_t)MAXBLK * 256 * 2048 <= WS_END, "moe buffers");
static_assert(WS_Y1 >= WS_ACT && WS_Y1 + (size_t)T * D * 2 <= WS_MRG, "y1 (P5 -> P6) clear of the buffers P6 writes");
constexpr int CW_BAR = 4096;

constexpr int RING_BYTES = 131072, LDSCTL_OFF = RING_BYTES, LDS_BYTES = 163840, RTAB_OFF = LDSCTL_OFF + 12288, RTAB_UNITS = 34, ETAB_OFF = LDSCTL_OFF + 5120, ETAB_UNITS = 64, UTAB_OFF = LDSCTL_OFF + 5376, UTAB_UNITS = 64;
constexpr int NWAVES = 8;

typedef unsigned short bf16;
typedef unsigned v4u __attribute__((ext_vector_type(4)));
typedef unsigned v2u __attribute__((ext_vector_type(2)));
typedef float f32x4 __attribute__((ext_vector_type(4)));
typedef float f32x16 __attribute__((ext_vector_type(16)));
typedef float f32x2 __attribute__((ext_vector_type(2)));
typedef short bf16x8 __attribute__((ext_vector_type(8)));
typedef unsigned u32x4v __attribute__((ext_vector_type(4)));
typedef __bf16 bf16x2v __attribute__((ext_vector_type(2)));
__device__ __forceinline__ unsigned pkbf(float lo, float hi) { const f32x2 v = {lo, hi}; return __builtin_bit_cast(unsigned, __builtin_convertvector(v, bf16x2v)); }
#define LDS_WAIT() asm volatile("s_waitcnt lgkmcnt(0)" ::: "memory")
#define LDS_BARRIER() do { asm volatile("s_waitcnt lgkmcnt(0)" ::: "memory"); __builtin_amdgcn_s_barrier(); asm volatile("" ::: "memory"); } while (0)
__device__ __forceinline__ unsigned f2bf(float f) { unsigned u = __builtin_bit_cast(unsigned, f); return (u + 0x7fffu + ((u >> 16) & 1u)) >> 16; }
__device__ __forceinline__ unsigned pk2(float lo, float hi) { return f2bf(lo) | (f2bf(hi) << 16); }
__device__ __forceinline__ float bflo(unsigned w) { return __uint_as_float(w << 16); }
__device__ __forceinline__ float bfhi(unsigned w) { return __uint_as_float(w & 0xffff0000u); }
__device__ __forceinline__ float bf1(bf16 h) { return __uint_as_float((unsigned)h << 16); }
__device__ __forceinline__ int ld_agent(const int* p) { return (int)__hip_atomic_load((unsigned*)p, __ATOMIC_RELAXED, __HIP_MEMORY_SCOPE_AGENT); }
template <int CTRL> __device__ __forceinline__ float dpp_add(float v) { const int t = __builtin_amdgcn_update_dpp(0, __float_as_int(v), CTRL, 0xf, 0xf, true); return v + __int_as_float(t); }
__device__ __forceinline__ float wave_sum(float v) {
    v = dpp_add<0xB1>(v); v = dpp_add<0x4E>(v); v = dpp_add<0x141>(v); v = dpp_add<0x140>(v);
    const int iv = __float_as_int(v);
    return (__int_as_float(__builtin_amdgcn_readlane(iv, 0)) + __int_as_float(__builtin_amdgcn_readlane(iv, 16))) + (__int_as_float(__builtin_amdgcn_readlane(iv, 32)) + __int_as_float(__builtin_amdgcn_readlane(iv, 48)));
}

#define XB_TMO      128
#define XB_XCNT(j)  (256  + 64 * (j))
#define XB_XSUB(j)  (1280 + 64 * (j))
#define XB_XGEN(j)  (2304 + 64 * (j))
#define XB_TOP      3328
#define XB_TOPGEN   3392
#define XCD_BAR_WORDS 3456
#define XB_SPIN_CAP (1u << 18)
__device__ __forceinline__ unsigned xb_ld(unsigned* p)              { return __hip_atomic_load(p, __ATOMIC_RELAXED, __HIP_MEMORY_SCOPE_AGENT); }
__device__ __forceinline__ unsigned xb_add(unsigned* p, unsigned v) { return __hip_atomic_fetch_add(p, v, __ATOMIC_RELAXED, __HIP_MEMORY_SCOPE_AGENT); }
__device__ __forceinline__ unsigned xb_xcc_id() { return (unsigned)__builtin_amdgcn_s_getreg((3 << 11) | 20) & 0xFu; }
#define XB_SPIN(cond, bar) do { unsigned _sp = 0; while (cond) { __builtin_amdgcn_s_sleep(1); \
    if ((++_sp & 255u) == 0u) { if (xb_ld(&(bar)[XB_TMO])) break; if (_sp > XB_SPIN_CAP) { atomicAdd(&(bar)[XB_TMO], 1u); break; } } } } while (0)
struct XcdBarrier { unsigned* bar; unsigned x; volatile LAS unsigned* st; };
__device__ __forceinline__ XcdBarrier xcd_barrier_post(unsigned* bar, volatile LAS unsigned* st) {
    XcdBarrier b; b.bar = bar; b.x = xb_xcc_id(); b.st = st;
    if (threadIdx.x == 0) (void)xb_add(&bar[XB_XCNT(b.x)], 1u);
    return b;
}
__device__ __forceinline__ void xcd_barrier_complete(unsigned* bar, unsigned x, unsigned& nloc, unsigned& nx) {
    const unsigned G = gridDim.x * gridDim.y * gridDim.z;
    unsigned sum, cnt, mine, sp = 0u;
    for (;;) {
        sum = 0u; cnt = 0u; mine = 0u;
#pragma unroll
        for (unsigned j = 0; j < 16; ++j) { const unsigned c = xb_ld(&bar[XB_XCNT(j)]); sum += c; cnt += (c > 0u) ? 1u : 0u; mine = (j == x) ? c : mine; }
        if (sum == G) break;
        __builtin_amdgcn_s_sleep(1);
        if ((++sp & 255u) == 0u) { if (xb_ld(&bar[XB_TMO])) break; if (sp > XB_SPIN_CAP) { atomicAdd(&bar[XB_TMO], 1u); break; } }
    }
    nloc = mine > 0u ? mine : 1u; nx = cnt > 0u ? cnt : 1u;
}
__device__ __forceinline__ void xcd_barrier(const XcdBarrier& b) {
    asm volatile("s_waitcnt vmcnt(0)" ::: "memory");
    __syncthreads();
    if (threadIdx.x == 0) {
        unsigned* bar = b.bar;
        __builtin_amdgcn_s_waitcnt(0);
        unsigned nloc = b.st[0], nx = b.st[1];
        if (nloc == 0u) { xcd_barrier_complete(bar, b.x, nloc, nx); b.st[0] = nloc; b.st[1] = nx; }
        const unsigned old = xb_add(&bar[XB_XSUB(b.x)], 1u);
        const unsigned gen = old / nloc;
        if (old + 1u == (gen + 1u) * nloc) {
            __builtin_amdgcn_fence(__ATOMIC_RELEASE, "agent");
            asm volatile("s_waitcnt vmcnt(0)" ::: "memory");
            const unsigned og = xb_add(&bar[XB_TOP], 1u);
            const unsigned tg = og / nx;
            if (og + 1u == (tg + 1u) * nx) xb_add(&bar[XB_TOPGEN], 1u);
            else XB_SPIN(xb_ld(&bar[XB_TOPGEN]) == tg, bar);
            __builtin_amdgcn_fence(__ATOMIC_ACQUIRE, "agent");
            xb_add(&bar[XB_XGEN(b.x)], 1u);
            asm volatile("s_waitcnt vmcnt(0)" ::: "memory");
        } else {
            XB_SPIN(xb_ld(&bar[XB_XGEN(b.x)]) == gen, bar);
            __builtin_amdgcn_fence(__ATOMIC_ACQUIRE, "agent");
            asm volatile("s_waitcnt vmcnt(0)" ::: "memory");
        }
    }
    __syncthreads();
}

__device__ __forceinline__ int rowmap_in(int c) {
    if (c < C_V) { const int w = c & 63; return (c & ~63) + 2 * (w & 31) + (w >> 5); }
    if (c >= C_LY && c < C_GA) { const int ch = c - C_LY, j = ch >> 7, pn = j < 4 ? 10 + j : 14 + j; return 256 * pn + (ch & 127); }
    if (c >= C_GL) { const int ch = c - C_GL, j = ch >> 7, pn = j < 4 ? 10 + j : 14 + j; return 256 * pn + 128 + (ch & 127); }
    return c; }
__device__ __forceinline__ int rowmap_e1(int c) { const int cc = c & 1023; return 256 * (cc >> 7) + (cc & 127) + ((c >> 10) << 7); }
template <int MAP>
__device__ __forceinline__ void transpose_item(const float* W, int K, int N, bf16* WT, LAS float* scr, int item, int lane) {
    const int nblk = N / 32, kb = item / nblk, nb = item % nblk, k0 = 64 * kb, n0 = 32 * nb;
    float tv_[32];
#pragma unroll
    for (int i = 0; i < 32; ++i) tv_[i] = W[(size_t)(k0 + 2 * i + (lane >> 5)) * N + n0 + (lane & 31)];
#pragma unroll
    for (int i = 0; i < 32; ++i) scr[(2 * i + (lane >> 5)) * 33 + (lane & 31)] = tv_[i];
    LDS_WAIT(); asm volatile("" ::: "memory");
    const int c = lane & 7;
#pragma unroll
    for (int j = 0; j < 4; ++j) { const int n = (lane >> 3) + 8 * j; const LAS float* s = scr + (8 * c) * 33 + n;
        v4u o; o.x = pk2(s[0 * 33], s[1 * 33]); o.y = pk2(s[2 * 33], s[3 * 33]); o.z = pk2(s[4 * 33], s[5 * 33]); o.w = pk2(s[6 * 33], s[7 * 33]);
        const int nn = n0 + n; const int row = MAP == 1 ? rowmap_in(nn) : (MAP == 2 ? rowmap_e1(nn) : nn);
        *(GAS v4u*)(WT + (size_t)row * K + k0 + 8 * c) = o; }
    LDS_WAIT(); asm volatile("" ::: "memory");
}

template <int MAP>
__device__ __forceinline__ void transpose_item8(const float* W, int K, int N, unsigned char* WT, LAS float* scr, int item, int lane) {
    const int nblk = N / 32, kb = item / nblk, nb = item % nblk, k0 = 64 * kb, n0 = 32 * nb;
    float tv_[32];
#pragma unroll
    for (int i = 0; i < 32; ++i) tv_[i] = W[(size_t)(k0 + 2 * i + (lane >> 5)) * N + n0 + (lane & 31)];
#pragma unroll
    for (int i = 0; i < 32; ++i) scr[(2 * i + (lane >> 5)) * 33 + (lane & 31)] = tv_[i];
    LDS_WAIT(); asm volatile("" ::: "memory");
    const int c = lane & 7;
#pragma unroll
    for (int j = 0; j < 4; ++j) { const int n = (lane >> 3) + 8 * j; const LAS float* sp = scr + (8 * c) * 33 + n;
        v2u o; o.x = pg8::pk4_fp8(sp[0 * 33] * pg8::W8_SCALE, sp[1 * 33] * pg8::W8_SCALE, sp[2 * 33] * pg8::W8_SCALE, sp[3 * 33] * pg8::W8_SCALE);
        o.y = pg8::pk4_fp8(sp[4 * 33] * pg8::W8_SCALE, sp[5 * 33] * pg8::W8_SCALE, sp[6 * 33] * pg8::W8_SCALE, sp[7 * 33] * pg8::W8_SCALE);
        const int nn = n0 + n; const int row = MAP == 2 ? rowmap_e1(nn) : nn;
        *(GAS v2u*)(WT + (size_t)row * K + k0 + 8 * c) = o; }
    LDS_WAIT(); asm volatile("" ::: "memory");
}

struct Args { const void* in[27]; float* out; unsigned char* ws; int ph_lo, ph_hi; };

__global__ void __launch_bounds__(NWAVES * 64, 2) fwd(Args args) {
    extern __shared__ __attribute__((aligned(16))) unsigned char lds[];
    LAS unsigned char* ldsb = (LAS unsigned char*)lds;
    volatile LAS unsigned* MISC = (volatile LAS unsigned*)(ldsb + LDSCTL_OFF);
    const int tid = threadIdx.x, lane = tid & 63, wave = __builtin_amdgcn_readfirstlane(tid >> 6);
    const int G = gridDim.x, bx = blockIdx.x;
    const int gw = bx * NWAVES + wave, NGW = G * NWAVES;
    unsigned char* ws = args.ws;
    unsigned* ctl = (unsigned*)(ws + WS_CTL);
#define x_in ((const float*)args.in[0])
#define cvec ((const float*)args.in[1])
#define positions ((const int*)args.in[2])
#define w_ada ((const float*)args.in[3])
#define b_ada ((const float*)args.in[4])
#define g_pre_mix ((const float*)args.in[5])
#define g_post_mix ((const float*)args.in[6])
#define w_in ((const float*)args.in[7])
#define b_in ((const float*)args.in[8])
#define sinks ((const float*)args.in[9])
#define conv_w ((const float*)args.in[10])
#define conv_b ((const float*)args.in[11])
#define w_rg ((const float*)args.in[12])
#define b_rg ((const float*)args.in[13])
#define w_ig ((const float*)args.in[14])
#define b_ig ((const float*)args.in[15])
#define lru_a ((const float*)args.in[16])
#define w_out ((const float*)args.in[17])
#define b_out ((const float*)args.in[18])
#define g_pre_ffn ((const float*)args.in[19])
#define g_post_ffn ((const float*)args.in[20])
#define w_router ((const float*)args.in[21])
#define b_router ((const float*)args.in[22])
#define w_e1 ((const float*)args.in[23])
#define b_e1 ((const float*)args.in[24])
#define w_e2 ((const float*)args.in[25])
#define b_e2 ((const float*)args.in[26])
#define out (args.out)
#define MOD ((float*)(args.ws + WS_MOD))
#define BINP ((float*)(args.ws + WS_BINP))
#define LC ((float*)(args.ws + WS_LC))
#define WRT ((float*)(args.ws + WS_WRT))
#define BE1P ((float*)(args.ws + WS_BE1P))
#define WRGT ((bf16*)(args.ws + WS_WRGT))
#define WIGT ((bf16*)(args.ws + WS_WIGT))
#define CNT ((int*)(args.ws + WS_CNT))
#define NBLK ((int*)(args.ws + WS_NBLK))
#define BLKE ((int*)(args.ws + WS_BLKE))
#define TKI ((int*)(args.ws + WS_TKI))
#define TKW ((float*)(args.ws + WS_TKW))
#define TKP ((int*)(args.ws + WS_TKP))
#define SLOT ((int*)(args.ws + WS_SLOT))
#define ROWTOK ((unsigned short*)(args.ws + WS_ROWTOK))
#define LP ((float*)(args.ws + WS_LP))
#define LH ((float*)(args.ws + WS_LH))
#define CS ((float*)(args.ws + WS_CS))
#define WBIN ((bf16*)(args.ws + WS_WBIN))
#define WBOUT ((bf16*)(args.ws + WS_WBOUT))
#define HB ((bf16*)(args.ws + WS_H))
#define PROJ ((bf16*)(args.ws + WS_PROJ))
#define MRG ((bf16*)(args.ws + WS_MRG))
#define Y1 ((bf16*)(args.ws + WS_Y1))
#define WBE1 ((unsigned char*)(args.ws + WS_WBE1))
#define WBE2 ((unsigned char*)(args.ws + WS_WBE2))
#define ACT ((unsigned char*)(args.ws + WS_ACT))
#define YP ((unsigned char*)(args.ws + WS_YP))
#define H8 ((unsigned char*)(args.ws + WS_H))

    for (int u = tid; u < (LDS_BYTES - LDSCTL_OFF) / 4; u += NWAVES * 64) ((LAS unsigned*)(ldsb + LDSCTL_OFF))[u] = 0u;
    __syncthreads();
    XcdBarrier bar; bar.bar = ctl + CW_BAR; bar.x = 0; bar.st = nullptr;
    if (MK_N_LAUNCHES == 1) bar = xcd_barrier_post(ctl + CW_BAR, MISC);
    const int lo = args.ph_lo, hi = args.ph_hi;
#define IN(k) (lo <= (k) && (k) < hi)
#define SEAM(k) do { if (IN(k) && IN((k) + 1)) xcd_barrier(bar); } while (0)
#ifndef LRU_STOP
#define LRU_STOP 0
#endif
#ifndef GEMM_PF
#define GEMM_PF false
#endif
#ifndef DBL_MASK
#define DBL_MASK 0
#endif
#define REP(k) _Pragma("unroll") for (int rep_ = 0; rep_ < 1 + ((DBL_MASK >> (k)) & 1); ++rep_)
#define REPBAR() do { if (rep_) xcd_barrier(bar); } while (0)

    REP(0) { REPBAR();
    if (IN(0)) {
        constexpr int NGV = 192;
        for (int cb = bx; cb < NGV; cb += G) {
            LAS float* sck = (LAS float*)ldsb;
            LAS float* red = (LAS float*)(ldsb + LDSCTL_OFF + 1024);
#pragma unroll 1
            for (int j0 = 0; j0 < 64; j0 += 32) {
                float cv[32];
#pragma unroll
                for (int j = 0; j < 32; ++j) cv[j] = cvec[tid + 512 * (j0 + j)];
#pragma unroll
                for (int j = 0; j < 32; ++j) { const int i = tid + 512 * (j0 + j), b = i >> 10, k = i & 1023; const float v = cv[j];
                    sck[k * 32 + ((((b >> 2) ^ (k & 7)) << 2) | (b & 3))] = v * __builtin_amdgcn_rcpf(1.0f + __builtin_amdgcn_exp2f(-1.4426950408889634f * v)); }
            }
            __syncthreads();
            const int h = lane >> 5, nl = lane & 31, n = cb * 32 + nl, kbase = wave * 128 + h * 64;
            float acc[32];
#pragma unroll
            for (int b = 0; b < 32; ++b) acc[b] = 0.f;
            float wv0[32], wv1[32];
#pragma unroll
            for (int kk = 0; kk < 32; ++kk) wv0[kk] = w_ada[(size_t)(kbase + kk) * 6144 + n];
#pragma unroll
            for (int kk = 0; kk < 32; ++kk) wv1[kk] = w_ada[(size_t)(kbase + 32 + kk) * 6144 + n];
            const LAS float* sp = sck + kbase * 32;
#pragma unroll
            for (int kk = 0; kk < 32; ++kk) { const float w = wv0[kk];
#pragma unroll
                for (int b4 = 0; b4 < 8; ++b4) { const f32x4 sv = *(const LAS f32x4*)(sp + kk * 32 + 4 * (b4 ^ (kk & 7)));
                    acc[4 * b4 + 0] += sv.x * w; acc[4 * b4 + 1] += sv.y * w; acc[4 * b4 + 2] += sv.z * w; acc[4 * b4 + 3] += sv.w * w; } }
#pragma unroll
            for (int kk = 0; kk < 32; ++kk) { const float w = wv1[kk];
#pragma unroll
                for (int b4 = 0; b4 < 8; ++b4) { const f32x4 sv = *(const LAS f32x4*)(sp + (32 + kk) * 32 + 4 * (b4 ^ (kk & 7)));
                    acc[4 * b4 + 0] += sv.x * w; acc[4 * b4 + 1] += sv.y * w; acc[4 * b4 + 2] += sv.z * w; acc[4 * b4 + 3] += sv.w * w; } }
#pragma unroll
            for (int b = 0; b < 32; ++b) acc[b] += __builtin_bit_cast(float, __builtin_amdgcn_ds_bpermute((lane ^ 32) << 2, __builtin_bit_cast(int, acc[b])));
#pragma unroll 1
            for (int w = 0; w < 8; ++w) {
                if (wave == w && lane < 32) {
#pragma unroll
                    for (int b = 0; b < 32; ++b) { if (w == 0) red[b * 32 + nl] = acc[b]; else red[b * 32 + nl] += acc[b]; } }
                __syncthreads();
            }
            { const float bb = b_ada[cb * 32 + (tid & 31)];
#pragma unroll
              for (int j = 0; j < 2; ++j) { const int b = (tid >> 5) + 16 * j; MOD[b * 6144 + cb * 32 + (tid & 31)] = red[b * 32 + (tid & 31)] + bb; } }
            __syncthreads();
        }
        {
            LAS float* scr = (LAS float*)(ldsb + wave * 16384);
            constexpr int I_IN = (D / 64) * (INW / 32), I_OUT = (D / 64) * (D / 32), I_ALL0 = I_IN + I_OUT + 128, I_HEAD = I_ALL0 - NGV * NWAVES;
            const bool split = (G == 256);
            int it, ie, st;
            if (split) { if (bx >= NGV) { it = (bx - NGV) * NWAVES + wave; ie = I_HEAD; st = (256 - NGV) * NWAVES; } else { it = I_HEAD + bx * NWAVES + wave; ie = I_ALL0; st = I_ALL0; } }
            else { it = gw; ie = I_ALL0; st = NGW; }
            for (; it < ie; it += st) {
                if (it < I_IN) transpose_item<1>(w_in, D, INW, WBIN, scr, it, lane);
                else if (it < I_IN + I_OUT) transpose_item<0>(w_out, D, D, WBOUT, scr, it - I_IN, lane);
                else { const int q = it - I_IN - I_OUT;
                    const int gsel = q >> 6, nb8 = (q >> 3) & 7, sub = q & 7;
                    transpose_item<0>((gsel ? w_ig : w_rg) + (size_t)nb8 * 16384, 128, 128, (gsel ? WIGT : WRGT) + (size_t)nb8 * 16384, scr, sub, lane); }
            }
        }
        {
            const bool split = (G == 256);
            if (!split || bx >= NGV) {
                const int gt = split ? ((bx - NGV) * NWAVES + wave) * 64 + lane : gw * 64 + lane, NT = split ? (256 - NGV) * NWAVES * 64 : NGW * 64;
                for (int i = gt; i < INW; i += NT) BINP[rowmap_in(i)] = b_in[i];
                for (int i = gt; i < NE * 2048; i += NT) { const int e = i >> 11, c = i & 2047; BE1P[e * 2048 + rowmap_e1(c)] = b_e1[i]; }
                for (int i = gt; i < D; i += NT) { const float a = lru_a[i]; const float sp = a > 20.f ? a : log1pf(expf(a)); LC[i] = -8.0f * sp; }
            }
        }
    }
    }
    SEAM(0);

    REP(1) { REPBAR();
    if (IN(1)) {
        for (int ci = gw; ci < T / 32; ci += NGW) {
            const int r0 = ci * 32, b = r0 >> 11; const float* md = MOD + b * 6144;
            f32x4 ga[4], gb[4];
#pragma unroll
            for (int j = 0; j < 4; ++j) { const int d = 4 * lane + 256 * j; const f32x4 g = *(const f32x4*)(g_pre_mix + d), sc = *(const f32x4*)(md + 1024 + d); ga[j] = g * (1.0f + sc); gb[j] = *(const f32x4*)(md + d); }
            for (int r = 0; r < 32; ++r) { const size_t row = (size_t)(r0 + r);
                f32x4 v[4]; float ss = 0.f;
#pragma unroll
                for (int j = 0; j < 4; ++j) { v[j] = *(const f32x4*)(x_in + row * D + 4 * lane + 256 * j); ss += (v[j].x * v[j].x + v[j].y * v[j].y) + (v[j].z * v[j].z + v[j].w * v[j].w); }
                const float rs = rsqrtf(wave_sum(ss) * (1.0f / D) + EPS);
#pragma unroll
                for (int j = 0; j < 4; ++j) { const f32x4 o = v[j] * rs * ga[j] + gb[j]; v2u w; w.x = pk2(o.x, o.y); w.y = pk2(o.z, o.w); *(v2u*)(HB + row * D + 4 * lane + 256 * j) = w; }
            }
        }
    }
    }
    SEAM(1);

    REP(2) { REPBAR();
    if (IN(2)) {
        pg8::Gemm g{HB, WBIN, D, nullptr, 0}; pg8::StaticOrder S; S.init(T / 256, INW / 256, G, bx);
        pg8::EpiIn E{PROJ, BINP, positions};
        LAS int* utab = (LAS int*)(ldsb + UTAB_OFF);
        { pg8::Unit ut; int t9 = threadIdx.x; asm volatile("" : "+v"(t9)); __syncthreads();
          if (t9 < UTAB_UNITS) utab[t9] = S.next(t9, ut) ? (ut.pm | (ut.pn << 16)) : -1;
          __syncthreads(); }
        pg8::TableOrder TS{utab};
        pg8::gemm_phase<pg8::EpiIn, pg8::TableOrder, true, true, false, false, GEMM_PF>(ldsb, g, TS, E);
    }
    }
    SEAM(2);

    REP(3) { REPBAR();
    if (IN(3)) {
        constexpr int A_KS = 144, A_VS = 520, A_VOFF = 256 * A_KS;
        const int hh = lane >> 5, ql = lane & 31;
        v4u kkn[4], vvn[4];
#define ATT_LOAD_KV(un_) do { const int kvh_ = (un_) & 3, nb_ = ((un_) >> 2) & 15, b_ = (un_) >> 6; const int t0_ = b_ * SEQ + nb_ * 128; \
            _Pragma("unroll") for (int i = 0; i < 4; ++i) { const int ck = tid + 512 * i, key = ck >> 3, dc = ck & 7; kkn[i] = (v4u){0u, 0u, 0u, 0u}; vvn[i] = (v4u){0u, 0u, 0u, 0u}; \
                if (nb_ > 0 || key >= 128) { const size_t ro = (size_t)(t0_ - 128 + key) * INW + 64 * kvh_ + 8 * dc; kkn[i] = *(const v4u*)(PROJ + ro + C_K); vvn[i] = *(const v4u*)(PROJ + ro + C_V); } } } while (0)
        if (bx < BATCH * 16 * 4) ATT_LOAD_KV(bx);
        for (int un = bx; un < BATCH * 16 * 4; un += G) {
            const int kvh = un & 3, nb = (un >> 2) & 15, b = un >> 6;
            const int t0 = b * SEQ + nb * 128;
            const int hq = kvh * 4 + (wave >> 1);
            bf16x8 qf[2][4];
#pragma unroll
            for (int qt = 0; qt < 2; ++qt)
#pragma unroll
                for (int sx = 0; sx < 4; ++sx) qf[qt][sx] = *(const bf16x8*)(PROJ + (size_t)(t0 + (wave & 1) * 64 + 32 * qt + ql) * INW + 64 * hq + 16 * sx + 8 * hh);
            LDS_BARRIER();
#pragma unroll
            for (int i = 0; i < 4; ++i) {
                const int ck = tid + 512 * i, key = ck >> 3, dc = ck & 7;
                const v4u kk = kkn[i], vv = vvn[i];
                *(LAS v4u*)(ldsb + key * A_KS + dc * 16) = kk;
                LAS unsigned short* vt = (LAS unsigned short*)(ldsb + A_VOFF + (8 * dc) * A_VS + key * 2);
                vt[0 * (A_VS / 2)] = (unsigned short)(vv.x & 0xffffu); vt[1 * (A_VS / 2)] = (unsigned short)(vv.x >> 16);
                vt[2 * (A_VS / 2)] = (unsigned short)(vv.y & 0xffffu); vt[3 * (A_VS / 2)] = (unsigned short)(vv.y >> 16);
                vt[4 * (A_VS / 2)] = (unsigned short)(vv.z & 0xffffu); vt[5 * (A_VS / 2)] = (unsigned short)(vv.z >> 16);
                vt[6 * (A_VS / 2)] = (unsigned short)(vv.w & 0xffffu); vt[7 * (A_VS / 2)] = (unsigned short)(vv.w >> 16);
            }
            LDS_BARRIER();
            if (un + G < BATCH * 16 * 4) ATT_LOAD_KV(un + G);
            const float sink2 = sinks[hq] * LOG2E;
#pragma unroll
            for (int qt = 0; qt < 2; ++qt) {
                const int i0 = (wave & 1) * 64 + 32 * qt, kt0 = i0 >> 5;
                const size_t qrow = (size_t)(t0 + i0 + ql);
                f32x16 S[5];
#pragma unroll
                for (int kk = 0; kk < 5; ++kk) {
#pragma unroll
                    for (int r = 0; r < 16; ++r) S[kk][r] = 0.f;
#pragma unroll
                    for (int sx = 0; sx < 4; ++sx) { const bf16x8 kf = *(const LAS bf16x8*)(ldsb + (32 * (kt0 + kk) + ql) * A_KS + 32 * sx + 16 * hh);
                        S[kk] = __builtin_amdgcn_mfma_f32_32x32x16_bf16(kf, qf[qt][sx], S[kk], 0, 0, 0); }
                }
#pragma unroll
                for (int r = 0; r < 16; ++r) { const int cr = (r & 3) + 8 * (r >> 2) + 4 * hh; if (!(cr > ql)) S[0][r] = -INFINITY; if (!(cr <= ql)) S[4][r] = -INFINITY; }
                if (nb == 0) {
#pragma unroll
                    for (int kk = 0; kk < 4; ++kk) if (kt0 + kk < 4) {
#pragma unroll
                        for (int r = 0; r < 16; ++r) S[kk][r] = -INFINITY; }
                }
                float m = sink2;
#pragma unroll
                for (int kk = 0; kk < 5; ++kk)
#pragma unroll
                    for (int r = 0; r < 16; ++r) m = fmaxf(m, S[kk][r]);
                m = fmaxf(m, __shfl_xor(m, 32));
                float l = 0.f;
#pragma unroll
                for (int kk = 0; kk < 5; ++kk)
#pragma unroll
                    for (int r = 0; r < 16; ++r) { const float p = __builtin_amdgcn_exp2f(S[kk][r] - m); S[kk][r] = p; l += p; }
                l += __shfl_xor(l, 32);
                l += __builtin_amdgcn_exp2f(sink2 - m);
                f32x16 O0, O1;
#pragma unroll
                for (int r = 0; r < 16; ++r) { O0[r] = 0.f; O1[r] = 0.f; }
#pragma unroll
                for (int kk = 0; kk < 5; ++kk)
#pragma unroll
                    for (int s2 = 0; s2 < 2; ++s2) {
                        u32x4v pw; pw.x = pkbf(S[kk][8 * s2 + 0], S[kk][8 * s2 + 1]); pw.y = pkbf(S[kk][8 * s2 + 2], S[kk][8 * s2 + 3]); pw.z = pkbf(S[kk][8 * s2 + 4], S[kk][8 * s2 + 5]); pw.w = pkbf(S[kk][8 * s2 + 6], S[kk][8 * s2 + 7]);
                        const bf16x8 pf = __builtin_bit_cast(bf16x8, pw);
                        const int kb = (32 * (kt0 + kk) + 16 * s2 + 4 * hh) * 2;
                        { const v2u a0 = *(const LAS v2u*)(ldsb + A_VOFF + ql * A_VS + kb), a1 = *(const LAS v2u*)(ldsb + A_VOFF + ql * A_VS + kb + 16);
                          u32x4v vw; vw.x = a0.x; vw.y = a0.y; vw.z = a1.x; vw.w = a1.y; O0 = __builtin_amdgcn_mfma_f32_32x32x16_bf16(__builtin_bit_cast(bf16x8, vw), pf, O0, 0, 0, 0); }
                        { const v2u a0 = *(const LAS v2u*)(ldsb + A_VOFF + (32 + ql) * A_VS + kb), a1 = *(const LAS v2u*)(ldsb + A_VOFF + (32 + ql) * A_VS + kb + 16);
                          u32x4v vw; vw.x = a0.x; vw.y = a0.y; vw.z = a1.x; vw.w = a1.y; O1 = __builtin_amdgcn_mfma_f32_32x32x16_bf16(__builtin_bit_cast(bf16x8, vw), pf, O1, 0, 0, 0); }
                    }
                const float il = __builtin_amdgcn_rcpf(l);
                bf16* orow = HB + qrow * D + 64 * hq + 4 * hh;
#pragma unroll
                for (int g4 = 0; g4 < 4; ++g4) {
                    v2u w0; w0.x = pkbf(O0[4 * g4 + 0] * il, O0[4 * g4 + 1] * il); w0.y = pkbf(O0[4 * g4 + 2] * il, O0[4 * g4 + 3] * il); *(v2u*)(orow + 8 * g4) = w0;
                    v2u w1; w1.x = pkbf(O1[4 * g4 + 0] * il, O1[4 * g4 + 1] * il); w1.y = pkbf(O1[4 * g4 + 2] * il, O1[4 * g4 + 3] * il); *(v2u*)(orow + 32 + 8 * g4) = w1;
                }
            }
        }
        __syncthreads();
    }
    }
    SEAM(3);
    {
        constexpr int pass = 1;
        _Pragma("unroll") for (int rep_ = 0; rep_ < 1 + ((DBL_MASK >> 4) & 1); ++rep_) { REPBAR();
        if (IN(4)) {
            constexpr int L_RS = 272, L_HOFF = 128 * L_RS, L_RAW = 2 * 128 * L_RS, L_CW = L_RAW + 132 * 256;
            const int q4 = lane >> 4, el = 16 * wave + (lane & 15);
            int n_prev = -1;
            bf16x8 br[4], bi[4]; float brg = 0.f, big = 0.f, lc = 0.f;
            LAS float* cwt = (LAS float*)(ldsb + L_CW);
            for (int un2 = bx; un2 < BATCH * 8; un2 += G) {
              const int n = un2 & 7, b = un2 >> 3;
              float carry = 0.f;
#pragma unroll 1
              for (int c = 0; c < 16; ++c) {
                const int t0 = b * SEQ + c * 128;
                const int chg = n * 128 + el;
                if (n != n_prev) {
                    n_prev = n;
                    __syncthreads();
                    for (int i = tid; i < 5 * 128; i += 512) { const int tp = i >> 7, ch = i & 127; cwt[i] = tp < 4 ? conv_w[tp * 1024 + n * 128 + ch] : conv_b[n * 128 + ch]; }
#pragma unroll
                    for (int ks = 0; ks < 4; ++ks) { br[ks] = *(const bf16x8*)(WRGT + (size_t)n * 16384 + el * 128 + 32 * ks + 8 * q4); bi[ks] = *(const bf16x8*)(WIGT + (size_t)n * 16384 + el * 128 + 32 * ks + 8 * q4); }
                    brg = b_rg[chg]; big = b_ig[chg]; lc = LC[chg];
                }
#define LRU_ISSUE_RAW(c_) do { const unsigned rawl_ = (unsigned)__builtin_amdgcn_readfirstlane((int)(unsigned)(size_t)(ldsb + L_RAW)); \
                    for (int g_ = wave; g_ < 33; g_ += NWAVES) { const char* gb_ = (const char*)PROJ + ((size_t)((long)(b * SEQ + (c_) * 128 - 3 + 4 * g_)) * INW + C_LX + n * 128) * 2; \
                        pg8::glds16(gb_, (unsigned)((lane >> 4) * (INW * 2) + (lane & 15) * 16), rawl_ + (unsigned)(g_ * 1024)); } } while (0)
                if (c == 0) { LRU_ISSUE_RAW(0); asm volatile("s_waitcnt vmcnt(0)" ::: "memory"); }
                LDS_BARRIER();
                { const int cc = tid & 15;
                  float cw[4][8], cbv[8];
#pragma unroll
                  for (int tp = 0; tp < 5; ++tp) { const f32x4 w0 = *(const LAS f32x4*)(cwt + tp * 128 + 8 * cc), w1 = *(const LAS f32x4*)(cwt + tp * 128 + 8 * cc + 4);
                      if (tp < 4) { cw[tp][0] = w0.x; cw[tp][1] = w0.y; cw[tp][2] = w0.z; cw[tp][3] = w0.w; cw[tp][4] = w1.x; cw[tp][5] = w1.y; cw[tp][6] = w1.z; cw[tp][7] = w1.w; }
                      else { cbv[0] = w0.x; cbv[1] = w0.y; cbv[2] = w0.z; cbv[3] = w0.w; cbv[4] = w1.x; cbv[5] = w1.y; cbv[6] = w1.z; cbv[7] = w1.w; } }
#pragma unroll
                  for (int i = 0; i < 4; ++i) {
                      const int tok = (tid >> 4) + 32 * i, sl = c * 128 + tok;
                      float o[8];
#pragma unroll
                      for (int e = 0; e < 8; ++e) o[e] = cbv[e];
#pragma unroll
                      for (int tp = 0; tp < 4; ++tp) {
                          v4u w = *(const LAS v4u*)(ldsb + L_RAW + (tok + tp) * 256 + cc * 16);
                          if (sl - 3 + tp < 0) w = (v4u){0u, 0u, 0u, 0u};
                          o[0] += bflo(w.x) * cw[tp][0]; o[1] += bfhi(w.x) * cw[tp][1]; o[2] += bflo(w.y) * cw[tp][2]; o[3] += bfhi(w.y) * cw[tp][3];
                          o[4] += bflo(w.z) * cw[tp][4]; o[5] += bfhi(w.z) * cw[tp][5]; o[6] += bflo(w.w) * cw[tp][6]; o[7] += bfhi(w.w) * cw[tp][7];
                      }
                      v4u pw; pw.x = pkbf(o[0], o[1]); pw.y = pkbf(o[2], o[3]); pw.z = pkbf(o[4], o[5]); pw.w = pkbf(o[6], o[7]);
                      *(LAS v4u*)(ldsb + tok * L_RS + cc * 16) = pw;
                  } }
                LDS_BARRIER();
                if (c + 1 < 16) LRU_ISSUE_RAW(c + 1);
                v4u mly[4], mga[4], mat[4];
                { const int cc0 = tid & 15, chg00 = n * 128 + 8 * cc0;
#pragma unroll
                  for (int i = 0; i < 4; ++i) { const size_t tg = (size_t)(t0 + (tid >> 4) + 32 * i); const bf16* pr = PROJ + tg * INW + chg00;
                      mly[i] = *(const v4u*)(pr + C_LY); mga[i] = *(const v4u*)(pr + C_GA); mat[i] = *(const v4u*)(HB + tg * D + chg00); }
                  asm volatile("" ::: "memory"); }
                if (LRU_STOP == 1 && rep_ == 0 && ((DBL_MASK >> 4) & 1)) continue;
                f32x4 R[8], I[8];
                { bf16x8 afc[4], afn[4];
#pragma unroll
                  for (int ks = 0; ks < 4; ++ks) afc[ks] = *(const LAS bf16x8*)(ldsb + (lane & 15) * L_RS + 64 * ks + 16 * q4);
#pragma unroll
                  for (int m = 0; m < 8; ++m) { R[m] = (f32x4){0.f, 0.f, 0.f, 0.f}; I[m] = (f32x4){0.f, 0.f, 0.f, 0.f};
                      if (m < 7) {
#pragma unroll
                          for (int ks = 0; ks < 4; ++ks) afn[ks] = *(const LAS bf16x8*)(ldsb + (16 * (m + 1) + (lane & 15)) * L_RS + 64 * ks + 16 * q4); }
#pragma unroll
                      for (int ks = 0; ks < 4; ++ks) { R[m] = __builtin_amdgcn_mfma_f32_16x16x32_bf16(afc[ks], br[ks], R[m], 0, 0, 0); I[m] = __builtin_amdgcn_mfma_f32_16x16x32_bf16(afc[ks], bi[ks], I[m], 0, 0, 0); }
#pragma unroll
                      for (int ks = 0; ks < 4; ++ks) afc[ks] = afn[ks]; } }
#pragma unroll
                for (int m = 0; m < 8; ++m)
#pragma unroll
                    for (int r = 0; r < 4; ++r) {
                        const int tok = 16 * m + 4 * q4 + r;
                        const float xv = bf1(*(const LAS unsigned short*)(ldsb + tok * L_RS + el * 2));
                        const float rs = pg8::sigm(R[m][r] + brg), is = pg8::sigm(I[m][r] + big);
                        const float la = lc * rs, av = __builtin_amdgcn_exp2f(1.4426950408889634f * la), mult = __builtin_amdgcn_sqrtf(fmaxf(1.0f - av * av, 0.0f));
                        R[m][r] = av; I[m][r] = mult * (is * xv);
                    }
                if (LRU_STOP == 2 && rep_ == 0 && ((DBL_MASK >> 4) & 1)) { asm volatile("" :: "v"(R[0]), "v"(I[0]), "v"(R[7]), "v"(I[7])); continue; }
                float sA[8], sH[8], Ae[8], He[8], At[8], Ht[8];
#pragma unroll
                for (int m = 0; m < 8; ++m) { float A = R[m][0], H = I[m][0];
#pragma unroll
                    for (int r = 1; r < 4; ++r) { H = R[m][r] * H + I[m][r]; A *= R[m][r]; }
                    sA[m] = A; sH[m] = H; }
#pragma unroll
                for (int m = 0; m < 8; ++m) { const float Ap = __shfl_up(sA[m], 16), Hp = __shfl_up(sH[m], 16); if (q4 >= 1) { sH[m] = sA[m] * Hp + sH[m]; sA[m] = sA[m] * Ap; } }
#pragma unroll
                for (int m = 0; m < 8; ++m) { const float Ap = __shfl_up(sA[m], 32), Hp = __shfl_up(sH[m], 32); if (q4 >= 2) { sH[m] = sA[m] * Hp + sH[m]; sA[m] = sA[m] * Ap; } }
#pragma unroll
                for (int m = 0; m < 8; ++m) { Ae[m] = __shfl_up(sA[m], 16); He[m] = __shfl_up(sH[m], 16); if (q4 == 0) { Ae[m] = 1.0f; He[m] = 0.0f; }
                    At[m] = __shfl(sA[m], 48 + (lane & 15)); Ht[m] = __shfl(sH[m], 48 + (lane & 15)); }
#pragma unroll
                for (int m = 0; m < 8; ++m) {
                    if (pass == 1) {
                        float hp = Ae[m] * carry + He[m];
#pragma unroll
                        for (int r = 0; r < 4; ++r) { hp = R[m][r] * hp + I[m][r]; *(LAS unsigned short*)(ldsb + L_HOFF + (16 * m + 4 * q4 + r) * L_RS + el * 2) = (unsigned short)(pkbf(hp, 0.f) & 0xffffu); }
                    }
                    carry = At[m] * carry + Ht[m];
                }
                if (LRU_STOP == 3 && rep_ == 0 && ((DBL_MASK >> 4) & 1)) continue;
                {
                    const int cc = tid & 15, chg0 = n * 128 + 8 * cc;
                    LDS_BARRIER();
#pragma unroll
                    for (int i = 0; i < 4; ++i) {
                        const int tok = (tid >> 4) + 32 * i; const size_t tg = (size_t)(t0 + tok);
                        const v4u hv = *(const LAS v4u*)(ldsb + L_HOFF + tok * L_RS + cc * 16);
                        const v4u ly = mly[i], ga = mga[i], at = mat[i];
                        v4u ow;
                        ow.x = pkbf(bflo(ga.x) * bflo(at.x) + bflo(hv.x) * bflo(ly.x), bfhi(ga.x) * bfhi(at.x) + bfhi(hv.x) * bfhi(ly.x));
                        ow.y = pkbf(bflo(ga.y) * bflo(at.y) + bflo(hv.y) * bflo(ly.y), bfhi(ga.y) * bfhi(at.y) + bfhi(hv.y) * bfhi(ly.y));
                        ow.z = pkbf(bflo(ga.z) * bflo(at.z) + bflo(hv.z) * bflo(ly.z), bfhi(ga.z) * bfhi(at.z) + bfhi(hv.z) * bfhi(ly.z));
                        ow.w = pkbf(bflo(ga.w) * bflo(at.w) + bflo(hv.w) * bflo(ly.w), bfhi(ga.w) * bfhi(at.w) + bfhi(hv.w) * bfhi(ly.w));
                        *(v4u*)(MRG + tg * D + chg0) = ow;
                    }
                }
              }
            }
            LDS_BARRIER();
        }
        }
        SEAM(4);
    }

    REP(5) { REPBAR();
    if (IN(5)) {
        pg8::Gemm g{MRG, WBOUT, D, nullptr, 0}; pg8::StaticOrder S; S.init(T / 256, D / 256, G, bx);
        pg8::EpiBf16 E{Y1, D, b_out};
        LAS int* utab = (LAS int*)(ldsb + UTAB_OFF);
        { pg8::Unit ut; int t9 = threadIdx.x; asm volatile("" : "+v"(t9)); __syncthreads();
          if (t9 < UTAB_UNITS) utab[t9] = S.next(t9, ut) ? (ut.pm | (ut.pn << 16)) : -1;
          __syncthreads(); }
        pg8::TableOrder TS{utab};
        pg8::gemm_phase<pg8::EpiBf16, pg8::TableOrder, true, true, false, false, GEMM_PF>(ldsb, g, TS, E);
    }
    }
    SEAM(5);

    REP(6) { REPBAR();
    if (IN(6)) {
        _Pragma("unroll") for (int rp_ = 0; rp_ < 1 + ((DBL_MASK >> 10) & 1); ++rp_)
        {
            LAS float* scr = (LAS float*)(ldsb + wave * 16384);
            constexpr int I_E1 = (D / 64) * (2048 / 32), I_E2 = (D / 64) * (D / 32), I_ALL = NE * (I_E1 + I_E2);
#define CV_DECODE(it_, W_, WT_, N_, k0_, n0_, m2_) do { const int i_ = (it_); if (i_ < NE * I_E1) { const int e_ = i_ / I_E1, r_ = i_ - e_ * I_E1; W_ = w_e1 + (size_t)e_ * D * 2048; WT_ = WBE1 + (size_t)e_ * 2048 * D; N_ = 2048; m2_ = true; k0_ = 64 * (r_ / 64); n0_ = 32 * (r_ % 64); } \
                else { const int q_ = i_ - NE * I_E1, e_ = q_ / I_E2, r_ = q_ - e_ * I_E2; W_ = w_e2 + (size_t)e_ * D * D; WT_ = WBE2 + (size_t)e_ * D * D; N_ = D; m2_ = false; k0_ = 64 * (r_ / 32); n0_ = 32 * (r_ % 32); } } while (0)
#define CV_LOAD(it_, tv_) do { const float* W_; unsigned char* WT_; int N_, k0_, n0_; bool m2_; CV_DECODE(it_, W_, WT_, N_, k0_, n0_, m2_); (void)WT_; (void)m2_; \
                _Pragma("unroll") for (int i = 0; i < 32; ++i) tv_[i] = W_[(size_t)(k0_ + 2 * i + (lane >> 5)) * N_ + n0_ + (lane & 31)]; } while (0)
#define CV_FINISH(it_, tv_) do { const float* W_; unsigned char* WT_; int N_, k0_, n0_; bool m2_; CV_DECODE(it_, W_, WT_, N_, k0_, n0_, m2_); (void)W_; \
                _Pragma("unroll") for (int i = 0; i < 32; ++i) scr[(2 * i + (lane >> 5)) * 33 + (lane & 31)] = tv_[i]; \
                LDS_WAIT(); asm volatile("" ::: "memory"); \
                const int c_ = lane & 7; \
                _Pragma("unroll") for (int j = 0; j < 4; ++j) { const int n_ = (lane >> 3) + 8 * j; const LAS float* sp = scr + (8 * c_) * 33 + n_; \
                    v2u o; o.x = pg8::pk4_fp8(sp[0 * 33] * pg8::W8_SCALE, sp[1 * 33] * pg8::W8_SCALE, sp[2 * 33] * pg8::W8_SCALE, sp[3 * 33] * pg8::W8_SCALE); \
                    o.y = pg8::pk4_fp8(sp[4 * 33] * pg8::W8_SCALE, sp[5 * 33] * pg8::W8_SCALE, sp[6 * 33] * pg8::W8_SCALE, sp[7 * 33] * pg8::W8_SCALE); \
                    const int nn_ = n0_ + n_; const int row_ = m2_ ? rowmap_e1(nn_) : nn_; \
                    *(GAS v2u*)(WT_ + (size_t)row_ * D + k0_ + 8 * c_) = o; } \
                LDS_WAIT(); asm volatile("" ::: "memory"); } while (0)
            float ta[32], tb[32];
            int it = gw;
            if (it < I_ALL) {
                CV_LOAD(it, ta);
                for (;;) {
                    const int it2 = it + NGW; { const int c2 = it2 < I_ALL ? it2 : I_ALL - 1; CV_LOAD(c2, tb); }
                    CV_FINISH(it, ta);
                    if (it2 >= I_ALL) break;
                    const int it3 = it2 + NGW; { const int c3 = it3 < I_ALL ? it3 : I_ALL - 1; CV_LOAD(c3, ta); }
                    CV_FINISH(it2, tb);
                    if (it3 >= I_ALL) break;
                    it = it3;
                }
            }
#undef CV_DECODE
#undef CV_LOAD
#undef CV_FINISH
        }
        __syncthreads();
        constexpr int HT_RS = 1028;
        LAS float* Ht = (LAS float*)ldsb;
        LAS float* part = (LAS float*)(ldsb + 16 * HT_RS * 4);
        float wB[8][4][2];
#pragma unroll
        for (int sx = 0; sx < 8; ++sx)
#pragma unroll
            for (int i4 = 0; i4 < 4; ++i4)
#pragma unroll
                for (int nt = 0; nt < 2; ++nt) wB[sx][i4][nt] = w_router[(size_t)(128 * wave + 16 * sx + 4 * (lane >> 4) + i4) * NE + (lane & 15) + 16 * nt];
        volatile LAS unsigned* lcnt = MISC + 32;
        _Pragma("unroll") for (int rp_ = 0; rp_ < 1 + ((DBL_MASK >> 11) & 1) + ((DBL_MASK >> 12) & 1); ++rp_)
        for (int grp = bx; grp < NGRP; grp += G) {
            const bool lite_ = ((DBL_MASK >> 12) & 1) && rp_ == 0;
            __syncthreads();
            if (tid < 32) lcnt[tid] = 0u;
            __syncthreads();
            const int b = (grp * 256) >> 11; const float* md = MOD + b * 6144;
            LAS float* pcn = (LAS float*)(ldsb + LDSCTL_OFF + 1024);
            if (wave == 0) {
#pragma unroll
                for (int j = 0; j < 4; ++j) { const int d = 4 * lane + 256 * j;
                    *(LAS f32x4*)(pcn + d) = *(const f32x4*)(md + 2048 + d) * *(const f32x4*)(g_post_mix + d);
                    *(LAS f32x4*)(pcn + 1024 + d) = *(const f32x4*)(g_pre_ffn + d) * (1.0f + *(const f32x4*)(md + 4096 + d));
                    *(LAS f32x4*)(pcn + 2048 + d) = *(const f32x4*)(md + 3072 + d); } }
            __syncthreads();
#define A1(j) (*(const LAS f32x4*)(pcn + 4 * lane + 256 * (j)))
#define A2(j) (*(const LAS f32x4*)(pcn + 1024 + 4 * lane + 256 * (j)))
#define B2(j) (*(const LAS f32x4*)(pcn + 2048 + 4 * lane + 256 * (j)))
            const float brt = b_router[lane & 31];
            v2u yn[2][4]; f32x4 xn[2][4];
#pragma unroll
            for (int u = 0; u < 2; ++u) { const size_t ro = (size_t)(grp * 256 + wave + 8 * u) * D;
#pragma unroll
              for (int j = 0; j < 4; ++j) { yn[u][j] = *(const v2u*)(Y1 + ro + 4 * lane + 256 * j); xn[u][j] = *(const f32x4*)(x_in + ro + 4 * lane + 256 * j); } }
#pragma unroll 1
            for (int rr = wave; rr < 256; rr += 16) {
                int lane_o = threadIdx.x & 63; asm volatile("" : "+v"(lane_o)); const int lane = lane_o;
                f32x4 v[2][4];
#pragma unroll
                for (int u = 0; u < 2; ++u)
#pragma unroll
                    for (int j = 0; j < 4; ++j) v[u][j] = (f32x4){bflo(yn[u][j].x), bfhi(yn[u][j].x), bflo(yn[u][j].y), bfhi(yn[u][j].y)};
                float ss[2], r1[2], ss2[2], r2[2];
#pragma unroll
                for (int u = 0; u < 2; ++u) { ss[u] = 0.f;
#pragma unroll
                    for (int j = 0; j < 4; ++j) ss[u] += (v[u][j].x * v[u][j].x + v[u][j].y * v[u][j].y) + (v[u][j].z * v[u][j].z + v[u][j].w * v[u][j].w); }
#pragma unroll
                for (int u = 0; u < 2; ++u) r1[u] = rsqrtf(wave_sum(ss[u]) * (1.0f / D) + EPS);
#pragma unroll
                for (int u = 0; u < 2; ++u) { const size_t ro = (size_t)(grp * 256 + rr + 8 * u) * D; ss2[u] = 0.f;
#pragma unroll
                    for (int j = 0; j < 4; ++j) { v[u][j] = xn[u][j] + v[u][j] * r1[u] * A1(j);
                        *(f32x4*)(out + ro + 4 * lane + 256 * j) = v[u][j]; ss2[u] += (v[u][j].x * v[u][j].x + v[u][j].y * v[u][j].y) + (v[u][j].z * v[u][j].z + v[u][j].w * v[u][j].w); } }
                if (rr + 16 < 256) {
#pragma unroll
                    for (int u = 0; u < 2; ++u) { const size_t rn = (size_t)(grp * 256 + rr + 16 + 8 * u) * D;
#pragma unroll
                        for (int j = 0; j < 4; ++j) { yn[u][j] = *(const v2u*)(Y1 + rn + 4 * lane + 256 * j); xn[u][j] = *(const f32x4*)(x_in + rn + 4 * lane + 256 * j); } } }
#pragma unroll
                for (int u = 0; u < 2; ++u) r2[u] = rsqrtf(wave_sum(ss2[u]) * (1.0f / D) + EPS);
#pragma unroll
                for (int u = 0; u < 2; ++u) { const size_t ro = (size_t)(grp * 256 + rr + 8 * u) * D;
#pragma unroll
                    for (int j = 0; j < 4; ++j) { v[u][j] = v[u][j] * r2[u] * A2(j) + B2(j); *(unsigned*)(H8 + ro + 4 * lane + 256 * j) = pg8::pk4_fp8(v[u][j].x, v[u][j].y, v[u][j].z, v[u][j].w); } }
#pragma unroll
                for (int u = 0; u < 2; ++u)
#pragma unroll
                    for (int j = 0; j < 4; ++j) *(LAS f32x4*)(Ht + (wave + 8 * u) * HT_RS + 4 * lane + 256 * j) = v[u][j];
                LDS_BARRIER();
                if (!lite_) {
                    f32x4 pa0 = {0.f, 0.f, 0.f, 0.f}, pa1 = {0.f, 0.f, 0.f, 0.f};
#pragma unroll
                    for (int sx = 0; sx < 8; ++sx) { const f32x4 av = *(const LAS f32x4*)(Ht + (lane & 15) * HT_RS + 128 * wave + 16 * sx + 4 * (lane >> 4));
#pragma unroll
                        for (int i4 = 0; i4 < 4; ++i4) { pa0 = __builtin_amdgcn_mfma_f32_16x16x4f32(av[i4], wB[sx][i4][0], pa0, 0, 0, 0); pa1 = __builtin_amdgcn_mfma_f32_16x16x4f32(av[i4], wB[sx][i4][1], pa1, 0, 0, 0); } }
#pragma unroll
                    for (int r = 0; r < 4; ++r) { part[(wave * 16 + 4 * (lane >> 4) + r) * 32 + (lane & 15)] = pa0[r]; part[(wave * 16 + 4 * (lane >> 4) + r) * 32 + 16 + (lane & 15)] = pa1[r]; }
                }
                LDS_BARRIER();
                if (lite_) continue;
                float val = brt;
#pragma unroll
                for (int w8 = 0; w8 < 8; ++w8) val += part[(w8 * 16 + wave + 8 * (lane >> 5)) * 32 + (lane & 31)];
                const int myE = lane & 31;
                int rank = 0;
#pragma unroll
                for (int e = 0; e < 32; ++e) { const float v0 = __int_as_float(__builtin_amdgcn_readlane(__float_as_int(val), e)), v1 = __int_as_float(__builtin_amdgcn_readlane(__float_as_int(val), 32 + e));
                    const float ve = lane < 32 ? v0 : v1; rank += (ve > val || (ve == val && e < myE)) ? 1 : 0; }
                float tv[2][4]; int ti[2][4];
#pragma unroll
                for (int k = 0; k < 4; ++k) { const unsigned long long mk = __ballot(rank == k);
                    const int s0 = (int)__builtin_ctz((unsigned)mk), s1 = 32 + (int)__builtin_ctz((unsigned)(mk >> 32));
                    ti[0][k] = s0; ti[1][k] = s1 - 32; tv[0][k] = __int_as_float(__builtin_amdgcn_readlane(__float_as_int(val), s0)); tv[1][k] = __int_as_float(__builtin_amdgcn_readlane(__float_as_int(val), s1)); }
                if (lane == 0 || lane == 32) {
                    const int u = lane >> 5; const int t = grp * 256 + rr + 8 * u;
                    const float t0v = u ? tv[1][0] : tv[0][0], t1v = u ? tv[1][1] : tv[0][1], t2v = u ? tv[1][2] : tv[0][2], t3v = u ? tv[1][3] : tv[0][3];
                    const int i0 = u ? ti[1][0] : ti[0][0], i1 = u ? ti[1][1] : ti[0][1], i2 = u ? ti[1][2] : ti[0][2], i3 = u ? ti[1][3] : ti[0][3];
                    const float e1 = __expf(t1v - t0v), e2 = __expf(t2v - t0v), e3 = __expf(t3v - t0v); const float inv = 1.0f / (1.0f + e1 + e2 + e3);
                    const float wv[4] = {inv, e1 * inv, e2 * inv, e3 * inv}; const int iv[4] = {i0, i1, i2, i3};
#pragma unroll
                    for (int k = 0; k < 4; ++k) { const unsigned pos = __hip_atomic_fetch_add((LAS unsigned*)(ldsb + LDSCTL_OFF + 128) + iv[k], 1u, __ATOMIC_RELAXED, __HIP_MEMORY_SCOPE_WORKGROUP);
                        TKI[t * 4 + k] = iv[k]; TKW[t * 4 + k] = wv[k]; TKP[t * 4 + k] = (int)pos; }
                }
            }
#undef A1
#undef A2
#undef B2
            __syncthreads();
            if (tid < 32) CNT[grp * 32 + tid] = (int)lcnt[tid];
        }
    }
    }
    SEAM(6);

    {
        int tidl = threadIdx.x; asm volatile("" : "+v"(tidl));
        REP(7) { REPBAR();
        if (IN(7)) {
            const int tid = tidl;
            LAS int* gbl = (LAS int*)ldsb;
            LAS int* pst = gbl + NGRP * 32;
            LAS int* tot = pst + 32;
            LAS int* nbl = tot + 32;
            __syncthreads();
            if (tid < 32) { int run = 0; for (int g2 = 0; g2 < NGRP; ++g2) { gbl[g2 * 32 + tid] = run; run += ld_agent(CNT + g2 * 32 + tid); } tot[tid] = run; }
            __syncthreads();
            if (tid == 0) { int p = 0; for (int e = 0; e < 32; ++e) { pst[e] = p; p += ((tot[e] + 255) >> 8) << 8; } nbl[0] = p >> 8; }
            __syncthreads();
            const int nblk = nbl[0];
            if (bx == 0) {
                for (int pm = tid; pm < nblk; pm += 512) { int e = 0; for (int q = 0; q < 32; ++q) { const int pend = pst[q] + (((tot[q] + 255) >> 8) << 8); if (pend <= pm * 256) e = q + 1; } BLKE[pm] = e > 31 ? 31 : e; }
                if (tid == 0) NBLK[0] = nblk;
            }
            for (int i = bx * 512 + tid; i < T * 4; i += G * 512) {
                const int t = i >> 2, g2 = t >> 8;
                const int e = TKI[i]; const int slot = pst[e] + gbl[g2 * 32 + e] + TKP[i];
                SLOT[i] = slot; ROWTOK[slot] = (unsigned short)t;
            }
            for (int e = bx; e < 32; e += G) { const int r0 = pst[e] + tot[e], r1 = pst[e] + (((tot[e] + 255) >> 8) << 8);
                for (int r = r0 + tid; r < r1; r += 512) ROWTOK[r] = (unsigned short)0; }
            __syncthreads();
        }
        }
        SEAM(7);
        REP(8) { REPBAR();
        if (IN(8)) {
            const int nblk = ld_agent(NBLK);
            LAS int* etab = (LAS int*)(ldsb + ETAB_OFF);
            pg8::Gemm g{(const bf16*)H8, (const bf16*)WBE1, D, etab, (size_t)2048 * D}; pg8::StaticOrder S; S.init(nblk, 8, G, bx);
            pg8::EpiSwiglu8 E{ACT, BE1P, etab};
            LAS unsigned short* rtab = (LAS unsigned short*)(ldsb + RTAB_OFF);
            { pg8::Unit uu;
              int t8 = threadIdx.x; asm volatile("" : "+v"(t8));
              __syncthreads();
              for (int ui = 0; ui < RTAB_UNITS && S.next(ui, uu); ++ui) if (t8 < 256) rtab[ui * 256 + t8] = ROWTOK[uu.pm * 256 + t8];
              pg8::Unit ue; if (t8 < ETAB_UNITS && S.next(t8, ue)) etab[t8] = ld_agent(BLKE + ue.pm);
              __syncthreads(); }
            LAS int* utab = (LAS int*)(ldsb + UTAB_OFF);
            { pg8::Unit ut; int t9 = threadIdx.x; asm volatile("" : "+v"(t9)); __syncthreads();
              if (t9 < UTAB_UNITS) utab[t9] = S.next(t9, ut) ? (ut.pm | (ut.pn << 16)) : -1;
              __syncthreads(); }
            pg8::TableOrder TS{utab};
            pg8::gemm_phase<pg8::EpiSwiglu8, pg8::TableOrder, true, true, true, true, GEMM_PF>(ldsb, g, TS, E, rtab);
        }
        }
        SEAM(8);
        REP(9) { REPBAR();
        if (IN(9)) {
            const int nblk = ld_agent(NBLK);
            LAS int* etab = (LAS int*)(ldsb + ETAB_OFF);
            pg8::Gemm g{(const bf16*)ACT, (const bf16*)WBE2, D, etab, (size_t)D * D}; pg8::StaticOrder S; S.init(nblk, 4, G, bx);
            pg8::EpiExpOut8 E{YP, b_e2, etab};
            { pg8::Unit uu; int t8 = threadIdx.x; asm volatile("" : "+v"(t8));
              __syncthreads();
              if (t8 < ETAB_UNITS && S.next(t8, uu)) etab[t8] = ld_agent(BLKE + uu.pm);
              __syncthreads(); }
            LAS int* utab = (LAS int*)(ldsb + UTAB_OFF);
            { pg8::Unit ut; int t9 = threadIdx.x; asm volatile("" : "+v"(t9)); __syncthreads();
              if (t9 < UTAB_UNITS) utab[t9] = S.next(t9, ut) ? (ut.pm | (ut.pn << 16)) : -1;
              __syncthreads(); }
            pg8::TableOrder TS{utab};
            pg8::gemm_phase<pg8::EpiExpOut8, pg8::TableOrder, true, true, true, false, GEMM_PF>(ldsb, g, TS, E);
        }
        }
        SEAM(9);
        if (IN(10)) {
            int tid2 = threadIdx.x; asm volatile("" : "+v"(tid2)); const int lane = tid2 & 63;
            for (int ci = gw; ci < T / 32; ci += NGW) {
                const int r0 = ci * 32, b = r0 >> 11; const float* md = MOD + b * 6144;
                f32x4 A3[4];
#pragma unroll
                for (int j = 0; j < 4; ++j) { const int d = 8 * lane + 512 * (j >> 1) + 4 * (j & 1); A3[j] = *(const f32x4*)(md + 5120 + d) * *(const f32x4*)(g_post_ffn + d); }
                const int sl0 = SLOT[r0 * 4 + lane], sl1 = SLOT[r0 * 4 + 64 + lane]; const float wk0 = TKW[r0 * 4 + lane], wk1 = TKW[r0 * 4 + 64 + lane];
                v2u yn[4][2]; f32x4 xn[4];
#pragma unroll
                for (int k = 0; k < 4; ++k) { const int slot = __builtin_amdgcn_readlane(sl0, k); const unsigned char* yp = YP + (size_t)slot * D;
#pragma unroll
                    for (int jh = 0; jh < 2; ++jh) yn[k][jh] = *(const v2u*)(yp + 8 * lane + 512 * jh); }
#pragma unroll
                for (int j = 0; j < 4; ++j) xn[j] = *(const f32x4*)(out + (size_t)r0 * D + 8 * lane + 512 * (j >> 1) + 4 * (j & 1));
#pragma unroll 1
                for (int r = 0; r < 32; ++r) { const int t = r0 + r; const size_t ro = (size_t)t * D;
                    v2u yc[4][2]; f32x4 xc4[4]; float wk[4];
#pragma unroll
                    for (int k = 0; k < 4; ++k) { const int idx = (4 * r + k) & 63; wk[k] = __int_as_float(r < 16 ? __builtin_amdgcn_readlane(__float_as_int(wk0), idx) : __builtin_amdgcn_readlane(__float_as_int(wk1), idx));
                        yc[k][0] = yn[k][0]; yc[k][1] = yn[k][1]; }
#pragma unroll
                    for (int j = 0; j < 4; ++j) xc4[j] = xn[j];
                    if (r + 1 < 32) {
#pragma unroll
                        for (int k = 0; k < 4; ++k) { const int idx = (4 * (r + 1) + k) & 63; const int slot = (r + 1) < 16 ? __builtin_amdgcn_readlane(sl0, idx) : __builtin_amdgcn_readlane(sl1, idx); const unsigned char* yp = YP + (size_t)slot * D;
#pragma unroll
                            for (int jh = 0; jh < 2; ++jh) yn[k][jh] = *(const v2u*)(yp + 8 * lane + 512 * jh); }
#pragma unroll
                        for (int j = 0; j < 4; ++j) xn[j] = *(const f32x4*)(out + ro + D + 8 * lane + 512 * (j >> 1) + 4 * (j & 1));
                    }
                    f32x4 y[4];
#pragma unroll
                    for (int j = 0; j < 4; ++j) y[j] = (f32x4){0.f, 0.f, 0.f, 0.f};
#pragma unroll
                    for (int k = 0; k < 4; ++k)
#pragma unroll
                        for (int jh = 0; jh < 2; ++jh) { const v2u w = yc[k][jh];
                            const f32x2 a0 = __builtin_amdgcn_cvt_pk_f32_fp8((int)w.x, false), a1 = __builtin_amdgcn_cvt_pk_f32_fp8((int)w.x, true), a2 = __builtin_amdgcn_cvt_pk_f32_fp8((int)w.y, false), a3 = __builtin_amdgcn_cvt_pk_f32_fp8((int)w.y, true);
                            y[2 * jh].x += wk[k] * a0.x; y[2 * jh].y += wk[k] * a0.y; y[2 * jh].z += wk[k] * a1.x; y[2 * jh].w += wk[k] * a1.y;
                            y[2 * jh + 1].x += wk[k] * a2.x; y[2 * jh + 1].y += wk[k] * a2.y; y[2 * jh + 1].z += wk[k] * a3.x; y[2 * jh + 1].w += wk[k] * a3.y; }
                    float ss = 0.f;
#pragma unroll
                    for (int j = 0; j < 4; ++j) ss += (y[j].x * y[j].x + y[j].y * y[j].y) + (y[j].z * y[j].z + y[j].w * y[j].w);
                    const float rs = rsqrtf(wave_sum(ss) * (1.0f / D) + EPS);
#pragma unroll
                    for (int j = 0; j < 4; ++j) *(f32x4*)(out + ro + 8 * lane + 512 * (j >> 1) + 4 * (j & 1)) = xc4[j] + y[j] * rs * A3[j];
                }
            }
        }
    }
#undef IN
#undef SEAM
}
#undef x_in
#undef cvec
#undef positions
#undef w_ada
#undef b_ada
#undef g_pre_mix
#undef g_post_mix
#undef w_in
#undef b_in
#undef sinks
#undef conv_w
#undef conv_b
#undef w_rg
#undef b_rg
#undef w_ig
#undef b_ig
#undef lru_a
#undef w_out
#undef b_out
#undef g_pre_ffn
#undef g_post_ffn
#undef w_router
#undef b_router
#undef w_e1
#undef b_e1
#undef w_e2
#undef b_e2
#undef out
#undef MOD
#undef BINP
#undef LC
#undef WRT
#undef BE1P
#undef CNT
#undef WRGT
#undef WIGT
#undef NBLK
#undef BLKE
#undef TKI
#undef TKW
#undef TKP
#undef SLOT
#undef ROWTOK
#undef LP
#undef LH
#undef CS
#undef WBIN
#undef WBOUT
#undef HB
#undef PROJ
#undef MRG
#undef Y1
#undef WBE1
#undef WBE2
#undef YP
#undef H8
#undef ACT

extern "C" void kernel_launch(void* const* d_in, const int* in_sizes, int n_in, void* d_out, int out_size, void* d_ws, size_t ws_size, hipStream_t stream) {
    static int grid = 0;
    if (grid == 0) {
        if (n_in != 27 || out_size != T * D || ws_size < WS_END) { fprintf(stderr, "kernel_launch: unexpected shapes (n_in %d, out %d, ws %zu)\n", n_in, out_size, ws_size); grid = -1; return; }
        int dev = 0, cus = 0, per_cu = 0;
        if (hipGetDevice(&dev) != hipSuccess || hipDeviceGetAttribute(&cus, hipDeviceAttributeMultiprocessorCount, dev) != hipSuccess) { grid = -1; return; }
        if (hipFuncSetAttribute((const void*)fwd, hipFuncAttributeMaxDynamicSharedMemorySize, LDS_BYTES) != hipSuccess) { fprintf(stderr, "kernel_launch: hipFuncSetAttribute failed\n"); grid = -1; return; }
        if (hipOccupancyMaxActiveBlocksPerMultiprocessor(&per_cu, (const void*)fwd, NWAVES * 64, LDS_BYTES) != hipSuccess || per_cu < 1)
            fprintf(stderr, "kernel_launch: note: occupancy query reports %d workgroups per CU\n", per_cu);
        (void)hipGetLastError();
        grid = cus;
    }
    if (grid < 0) return;
    if (hipMemsetAsync((char*)d_ws + WS_CTL, 0, CTL_ZERO_BYTES, stream) != hipSuccess) return;
    Args a{};
    for (int i = 0; i < 27; ++i) a.in[i] = d_in[i];
    a.out = (float*)d_out; a.ws = (unsigned char*)d_ws;
    constexpr int NPH = 11;
    if (MK_N_LAUNCHES == 1) {
        a.ph_lo = 0; a.ph_hi = NPH;
        hipLaunchKernelGGL(fwd, dim3(grid), dim3(NWAVES * 64), LDS_BYTES, stream, a);
    } else {
        for (int p = 0; p < NPH; ++p) { a.ph_lo = p; a.ph_hi = p + 1; hipLaunchKernelGGL(fwd, dim3(grid), dim3(NWAVES * 64), LDS_BYTES, stream, a); }
    }
}
```

```cpp
#include <hip/hip_runtime.h>
#include <cstdio>
#include <cstdint>

#ifndef MK_N_LAUNCHES
#define MK_N_LAUNCHES 1
#endif

#ifndef FULL_LINE_F8
#define FULL_LINE_F8 true
#endif
#ifndef FULL_LINE_BF16
#define FULL_LINE_BF16 false
#endif
#define LAS __attribute__((address_space(3)))
#define GAS __attribute__((address_space(1)))

namespace pg8 {
#define PG8_LAS __attribute__((address_space(3)))
#define POS_LDS_OFF (131072 + 1024)
#define BIAS_LDS_OFF (131072 + 30720)
typedef unsigned short bf16_t;
typedef short bf16x8 __attribute__((ext_vector_type(8)));
typedef float f32x4 __attribute__((ext_vector_type(4)));
typedef unsigned u32x4 __attribute__((ext_vector_type(4)));
constexpr int BM = 256, BK = 64, HALF = 128, HTB = HALF * BK * 2, STAGE_BYTES = 8 * HTB, NXCD = 8, WGM = 8;

__host__ __device__ __forceinline__ int lds_byte(int r, int c) { const int st = (r >> 4) * 2 + (c >> 5), rr = r & 15, cc = c & 31, ob = rr * 64 + cc * 2; return st * 1024 + (ob ^ (((ob >> 9) & 1) << 5)); }
__host__ __device__ __forceinline__ void stage_rc(int b, int& R, int& C) { const int st = b / 1024, sb = b % 1024, swz = sb ^ (((sb >> 9) & 1) << 5); R = (st >> 1) * 16 + swz / 64; C = (st & 1) * 32 + (swz % 64) / 2; }
__host__ __device__ __forceinline__ int perm32(int rho) { const int n = rho >> 4, i = rho & 15; return 8 * (i >> 2) + 4 * n + (i & 3); }

struct Unit { int pm, pn; };
struct Gemm { const bf16_t* A; const bf16_t* Bt; int K; const PG8_LAS int* etab; size_t estride; };

__device__ __forceinline__ int rfl_s(int v) { int r; asm volatile("v_readfirstlane_b32 %0, %1" : "=s"(r) : "v"(v)); return r; }
__device__ __forceinline__ int ld_i32_agent(const int* p) { return (int)__hip_atomic_load((unsigned*)p, __ATOMIC_RELAXED, __HIP_MEMORY_SCOPE_AGENT); }

struct StaticOrder {
    int nM, nN, nwg, G, c;
    __host__ __device__ void init(int nM_, int nN_, int G_, int c_) { nM = nM_; nN = nN_; nwg = nM * nN; G = G_; c = c_; }
    __host__ __device__ bool next(int i, Unit& u) const {
        const long L = (long)i * G + c; if (L >= nwg) return false;
        int wgid = (int)L; { const int q = nwg / NXCD, r = nwg % NXCD, xcd = wgid % NXCD, off = wgid / NXCD; wgid = (xcd < r ? xcd * (q + 1) : r * (q + 1) + (xcd - r) * q) + off; }
        const int nig = WGM * nN, gid = wgid / nig, fm = gid * WGM, gsz = (nM - fm) < WGM ? (nM - fm) : WGM;
        u.pm = fm + ((wgid % nig) % gsz); u.pn = (wgid % nig) / gsz; return true;
    }
    __device__ __forceinline__ void a_ready(const Unit&) const {}
    __device__ __forceinline__ void done(const Unit&) const {}
};

struct TableOrder {
    const PG8_LAS int* tab;
    __device__ __forceinline__ bool next(int i, Unit& u) const { const int v = rfl_s(tab[i]); if (v < 0) return false; u.pm = v & 0xFFFF; u.pn = v >> 16; return true; }
    __device__ __forceinline__ void a_ready(const Unit&) const {}
    __device__ __forceinline__ void done(const Unit&) const {}
};

__device__ __forceinline__ unsigned cvt_pk_bf16(float lo, float hi) { unsigned r; asm volatile("v_cvt_pk_bf16_f32 %0, %1, %2" : "=v"(r) : "v"(lo), "v"(hi)); return r; }

__device__ __forceinline__ float sigm(float x) { return __builtin_amdgcn_rcpf(1.0f + __builtin_amdgcn_exp2f(-1.4426950408889634f * x)); }
__device__ __forceinline__ float gelu_tanh(float x) { const float u = -2.3022082114692686f * (x + 0.044715f * x * x * x); return x * __builtin_amdgcn_rcpf(1.0f + __builtin_amdgcn_exp2f(u)); }

__device__ __forceinline__ float gelu_sigm(float x, float g) {
    const float u = -2.3022082114692686f * (x + 0.044715f * x * x * x);
    return x * __builtin_amdgcn_rcpf((1.0f + __builtin_amdgcn_exp2f(u)) * (1.0f + __builtin_amdgcn_exp2f(-1.4426950408889634f * g))); }

constexpr int IN_W = 5632;
constexpr float QSCALE = 0.125f * 1.4426950408889634f;
struct EpiIn {
    static constexpr bool PERM = true, AFTER_DRAIN = false;
    static constexpr bool NEED_POS = true;
    bf16_t* O; const float* bias; const int* pos;
    __device__ __forceinline__ const float* bias_seg(const Unit& u, int) const { return bias + u.pn * BM; }
    __device__ __forceinline__ void operator()(const f32x4 (&acc)[2][2][4][2], const Unit& u, int wr, int wc, int fr, int fq, const PG8_LAS float* lb, const PG8_LAS int* lp) const {
        const int row0 = u.pm * BM + wr * 64 + fr; const int col0 = u.pn * BM + wc * 32 + 8 * fq;
        const int kind = u.pn <= 4 ? 0 : (u.pn <= 9 ? 1 : ((u.pn <= 13 || u.pn >= 18) ? 4 : 3));
        if (kind == 4) {
            const int j = u.pn <= 13 ? u.pn - 10 : u.pn - 14; const int cin = wc * 32 + 8 * fq;
            f32x4 b0[2], b1[2];
#pragma unroll
            for (int n = 0; n < 2; ++n) { b0[n] = *(const PG8_LAS f32x4*)(lb + 8 * fq + 4 * n); b1[n] = *(const PG8_LAS f32x4*)(lb + 32 + 8 * fq + 4 * n); }
#pragma unroll
            for (int ai = 0; ai < 2; ++ai)
#pragma unroll
                for (int m = 0; m < 4; ++m) { bf16_t* rowp = O + (size_t)(row0 + ai * HALF + m * 16) * IN_W + 2560 + j * HALF + cin;
                    f32x4 o[2];
#pragma unroll
                    for (int n = 0; n < 2; ++n) { const f32x4 ly = acc[ai][0][m][n] + b0[n], gl = acc[ai][1][m][n] + b1[n];
#pragma unroll
                        for (int e = 0; e < 4; ++e) o[n][e] = gelu_sigm(ly[e], gl[e]); }
                    u32x4 w; w.x = cvt_pk_bf16(o[0][0], o[0][1]); w.y = cvt_pk_bf16(o[0][2], o[0][3]); w.z = cvt_pk_bf16(o[1][0], o[1][1]); w.w = cvt_pk_bf16(o[1][2], o[1][3]);
                    *(u32x4*)rowp = w; }
            return;
        }
        const float qs = u.pn < 4 ? QSCALE : 1.0f;
        const int i0 = 16 * (wc & 1) + 4 * fq;
        float cf[4];
#pragma unroll
        for (int j = 0; j < 4; ++j) cf[j] = kind == 0 ? exp2f(-(float)(2 * (i0 + j)) * (13.287712379549449f / 64.0f)) * 0.15915494309189535f : 0.0f;
        f32x4 bv[2][2];
#pragma unroll
        for (int bj = 0; bj < 2; ++bj)
#pragma unroll
            for (int n = 0; n < 2; ++n) bv[bj][n] = *(const PG8_LAS f32x4*)(lb + bj * 32 + 8 * fq + 4 * n);
#pragma unroll
        for (int ai = 0; ai < 2; ++ai)
#pragma unroll
            for (int m = 0; m < 4; ++m) { const int row = row0 + ai * HALF + m * 16; bf16_t* rowp = O + (size_t)row * IN_W + col0;
                f32x4 c0 = {1.f, 0.f, 1.f, 0.f}, c1 = {1.f, 0.f, 1.f, 0.f};
                if (kind == 0) { const float pf = (float)lp[ai * 64 + m * 16 + fr]; float cc[4], sn[4];
#pragma unroll
                    for (int j = 0; j < 4; ++j) { const float hi = pf * cf[j]; const float fr_ = (hi - __builtin_rintf(hi)) + __builtin_fmaf(pf, cf[j], -hi); cc[j] = __builtin_amdgcn_cosf(fr_); sn[j] = __builtin_amdgcn_sinf(fr_); }
                    c0 = (f32x4){cc[0], sn[0], cc[1], sn[1]}; c1 = (f32x4){cc[2], sn[2], cc[3], sn[3]}; }
#pragma unroll
                for (int bj = 0; bj < 2; ++bj) { f32x4 v0 = acc[ai][bj][m][0] + bv[bj][0], v1 = acc[ai][bj][m][1] + bv[bj][1];
                    if (kind == 0) {
                        f32x4 o0, o1;
                        o0[0] = v0[0] * c0[0] - v0[1] * c0[1]; o0[1] = v0[1] * c0[0] + v0[0] * c0[1];
                        o0[2] = v0[2] * c0[2] - v0[3] * c0[3]; o0[3] = v0[3] * c0[2] + v0[2] * c0[3];
                        o1[0] = v1[0] * c1[0] - v1[1] * c1[1]; o1[1] = v1[1] * c1[0] + v1[0] * c1[1];
                        o1[2] = v1[2] * c1[2] - v1[3] * c1[3]; o1[3] = v1[3] * c1[2] + v1[2] * c1[3];
                        v0 = o0 * qs; v1 = o1 * qs;
                    } else if (kind == 2) {
#pragma unroll
                        for (int e = 0; e < 4; ++e) { v0[e] = gelu_tanh(v0[e]); v1[e] = gelu_tanh(v1[e]); }
                    } else if (kind == 3) {
#pragma unroll
                        for (int e = 0; e < 4; ++e) { v0[e] = sigm(v0[e]); v1[e] = sigm(v1[e]); }
                    }
                    u32x4 w; w.x = cvt_pk_bf16(v0[0], v0[1]); w.y = cvt_pk_bf16(v0[2], v0[3]); w.z = cvt_pk_bf16(v1[0], v1[1]); w.w = cvt_pk_bf16(v1[2], v1[3]);
                    *(u32x4*)(rowp + bj * HALF) = w; } }
    }
};
struct EpiF32 {
    static constexpr bool NEED_POS = false;
    static constexpr bool PERM = false, AFTER_DRAIN = false;
    float* O; int ldc; const float* bias;
    __device__ __forceinline__ const float* bias_seg(const Unit& u, int) const { return bias + u.pn * BM; }
    __device__ __forceinline__ void operator()(const f32x4 (&acc)[2][2][4][2], const Unit& u, int wr, int wc, int fr, int fq, const PG8_LAS float*, const PG8_LAS int*) const {
        const int col0 = u.pn * BM + wc * 32 + 4 * fq;
        f32x4 bv[2][2];
#pragma unroll
        for (int bj = 0; bj < 2; ++bj)
#pragma unroll
            for (int n = 0; n < 2; ++n) bv[bj][n] = *(const f32x4*)(bias + col0 + bj * HALF + n * 16);
#pragma unroll
        for (int ai = 0; ai < 2; ++ai)
#pragma unroll
            for (int m = 0; m < 4; ++m) { const int r = ai * HALF + wr * 64 + m * 16 + fr; const size_t off = (size_t)(u.pm * BM + r) * ldc + col0;
#pragma unroll
                for (int bj = 0; bj < 2; ++bj)
#pragma unroll
                    for (int n = 0; n < 2; ++n) *(f32x4*)(O + off + bj * HALF + n * 16) = acc[ai][bj][m][n] + bv[bj][n]; }
    }
};
struct EpiBf16 {
    static constexpr bool NEED_POS = false;
    static constexpr bool PERM = true, AFTER_DRAIN = false;
    bf16_t* O; int ldc; const float* bias;
    __device__ __forceinline__ const float* bias_seg(const Unit& u, int) const { return bias + u.pn * BM; }
    __device__ __forceinline__ void operator()(const f32x4 (&acc)[2][2][4][2], const Unit& u, int wr, int wc, int fr, int fq, const PG8_LAS float* lb, const PG8_LAS int*) const {
        const int row0 = u.pm * BM + wr * 64 + fr; const int col0 = u.pn * BM + wc * 32 + 8 * fq;
        f32x4 bv[2][2];
#pragma unroll
        for (int bj = 0; bj < 2; ++bj)
#pragma unroll
            for (int n = 0; n < 2; ++n) bv[bj][n] = *(const PG8_LAS f32x4*)(lb + bj * 32 + 8 * fq + 4 * n);
#pragma unroll
        for (int ai = 0; ai < 2; ++ai)
#pragma unroll
            for (int m = 0; m < 4; ++m) { bf16_t* rowp = O + (size_t)(row0 + ai * HALF + m * 16) * ldc + col0;
#pragma unroll
                for (int bj = 0; bj < 2; ++bj) { const f32x4 v0 = acc[ai][bj][m][0] + bv[bj][0], v1 = acc[ai][bj][m][1] + bv[bj][1];
                    u32x4 w; w.x = cvt_pk_bf16(v0[0], v0[1]); w.y = cvt_pk_bf16(v0[2], v0[3]); w.z = cvt_pk_bf16(v1[0], v1[1]); w.w = cvt_pk_bf16(v1[2], v1[3]);
                    *(u32x4*)(rowp + bj * HALF) = w; } }
    }
};
__device__ __forceinline__ unsigned pk4_fp8(float a, float b, float c, float d) {
    a = __builtin_amdgcn_fmed3f(a, -448.f, 448.f); b = __builtin_amdgcn_fmed3f(b, -448.f, 448.f); c = __builtin_amdgcn_fmed3f(c, -448.f, 448.f); d = __builtin_amdgcn_fmed3f(d, -448.f, 448.f);
    int p = 0; p = __builtin_amdgcn_cvt_pk_fp8_f32(a, b, p, false); p = __builtin_amdgcn_cvt_pk_fp8_f32(c, d, p, true); return (unsigned)p;
}
__device__ __forceinline__ unsigned pk4_fp8_nc(float a, float b, float c, float d) {
    int p = 0; p = __builtin_amdgcn_cvt_pk_fp8_f32(a, b, p, false); p = __builtin_amdgcn_cvt_pk_fp8_f32(c, d, p, true); return (unsigned)p;
}
constexpr float W8_SCALE = 32.0f, W8_INV = 1.0f / 32.0f;
struct EpiSwiglu8 {
    static constexpr bool NEED_POS = false;
    static constexpr bool PERM = true, AFTER_DRAIN = false;
    unsigned char* O; const float* bias  ; const PG8_LAS int* etab;
    __device__ __forceinline__ const float* bias_seg(const Unit& u, int ui) const { return bias + ((unsigned)rfl_s(etab[ui]) * 2048u + (unsigned)(u.pn * BM)); }
    __device__ __forceinline__ void operator()(const f32x4 (&acc)[2][2][4][2], const Unit& u, int wr, int wc, int fr, int fq, const PG8_LAS float* lb, const PG8_LAS int*) const {
        const int row0 = u.pm * BM + wr * 64 + fr; const int cin = wc * 32 + 8 * fq;
        f32x4 bv[2][2];
#pragma unroll
        for (int bj = 0; bj < 2; ++bj)
#pragma unroll
            for (int n = 0; n < 2; ++n) bv[bj][n] = *(const PG8_LAS f32x4*)(lb + bj * 32 + 8 * fq + 4 * n) + (bj ? 1.0f : 0.0f);
#pragma unroll
        for (int ai = 0; ai < 2; ++ai)
#pragma unroll
            for (int m = 0; m < 4; ++m) { unsigned char* rowp = O + (size_t)(row0 + ai * HALF + m * 16) * 1024 + u.pn * HALF + cin;
                f32x4 o[2];
#pragma unroll
                for (int n = 0; n < 2; ++n) { const f32x4 g = acc[ai][0][m][n] * W8_INV + bv[0][n], uu = acc[ai][1][m][n] * W8_INV + bv[1][n];
#pragma unroll
                    for (int q = 0; q < 4; ++q) { const float gc = fminf(g[q], 7.0f), uc1 = __builtin_amdgcn_fmed3f(uu[q], -6.0f, 8.0f);
                        o[n][q] = gc * uc1 * __builtin_amdgcn_rcpf(1.0f + __builtin_amdgcn_exp2f(-1.702f * 1.4426950408889634f * gc)); } }
                typedef unsigned u32x2 __attribute__((ext_vector_type(2)));
                u32x2 w; w.x = pk4_fp8_nc(o[0][0], o[0][1], o[0][2], o[0][3]); w.y = pk4_fp8_nc(o[1][0], o[1][1], o[1][2], o[1][3]);
                *(u32x2*)rowp = w; }
    }
};
struct EpiExpOut8 {
    static constexpr bool NEED_POS = false;
    static constexpr bool PERM = true, AFTER_DRAIN = false;
    unsigned char* O; const float* bias  ; const PG8_LAS int* etab;
    __device__ __forceinline__ const float* bias_seg(const Unit& u, int ui) const { return bias + ((unsigned)rfl_s(etab[ui]) * 1024u + (unsigned)(u.pn * BM)); }
    __device__ __forceinline__ void operator()(const f32x4 (&acc)[2][2][4][2], const Unit& u, int wr, int wc, int fr, int fq, const PG8_LAS float* lb, const PG8_LAS int*) const {
        const int row0 = u.pm * BM + wr * 64 + fr; const int col0 = u.pn * BM + wc * 32 + 8 * fq;
        f32x4 bv[2][2];
#pragma unroll
        for (int bj = 0; bj < 2; ++bj)
#pragma unroll
            for (int n = 0; n < 2; ++n) bv[bj][n] = *(const PG8_LAS f32x4*)(lb + bj * 32 + 8 * fq + 4 * n);
        typedef unsigned u32x2 __attribute__((ext_vector_type(2)));
#pragma unroll
        for (int ai = 0; ai < 2; ++ai)
#pragma unroll
            for (int m = 0; m < 4; ++m) { unsigned char* rowp = O + (size_t)(row0 + ai * HALF + m * 16) * 1024 + col0;
#pragma unroll
                for (int bj = 0; bj < 2; ++bj) { const f32x4 v0 = acc[ai][bj][m][0] * W8_INV + bv[bj][0], v1 = acc[ai][bj][m][1] * W8_INV + bv[bj][1];
                    u32x2 w; w.x = pk4_fp8(v0[0], v0[1], v0[2], v0[3]); w.y = pk4_fp8(v1[0], v1[1], v1[2], v1[3]);
                    *(u32x2*)(rowp + bj * HALF) = w; } }
    }
};

__device__ __forceinline__ void glds16(const char* gbase  , unsigned voff, unsigned m0v  ) {
    unsigned keep;
    asm volatile("s_mov_b32 %0, m0\n\ts_mov_b32 m0, %2\n\ts_nop 0\n\tglobal_load_lds_dwordx4 %1, %3\n\ts_mov_b32 m0, %0"
                 : "=&s"(keep) : "v"(voff), "s"(m0v), "s"(gbase) : "memory");
}
__device__ __forceinline__ void glds4(const char* gbase  , unsigned voff, unsigned m0v  ) {
    unsigned keep;
    asm volatile("s_mov_b32 %0, m0\n\ts_mov_b32 m0, %2\n\ts_nop 0\n\tglobal_load_lds_dword %1, %3\n\ts_mov_b32 m0, %0"
                 : "=&s"(keep) : "v"(voff), "s"(m0v), "s"(gbase) : "memory");
}
__device__ __forceinline__ const char* b_tile_ptr(const Gemm& g, const Unit& u, size_t tstep, int ui) {
    const char* p = (const char*)g.Bt + (size_t)u.pn * tstep;
    if (g.etab) p += (size_t)((unsigned)rfl_s(g.etab[ui]) * (unsigned)g.estride);
    return p;
}

typedef int i32x4 __attribute__((ext_vector_type(4)));
typedef int i32x8 __attribute__((ext_vector_type(8)));
template <class Epi, class Sched, bool ALIGN_EPI = false, bool SP2 = false, bool F8 = false, bool GATHER = false, bool PF = false>
__device__ __forceinline__ void gemm_phase(PG8_LAS unsigned char* lds, const Gemm g, const Sched& S, const Epi& E, const PG8_LAS unsigned short* rtab = nullptr) {
    int tid_ = threadIdx.x; asm volatile("" : "+v"(tid_));
    const int tid = tid_, wid = __builtin_amdgcn_readfirstlane(tid >> 6), lane = tid & 63, wr = wid >> 2, wc = wid & 3, fr = lane & 15, fq = lane >> 4;
    const int K = g.K, KB = F8 ? K : 2 * K, nt = KB / 128;
    constexpr bool FL = FULL_LINE_F8 ? (F8 || FULL_LINE_BF16) : false;
#define PG8_FSW(r15) ((((r15) >> 1) & 7) ^ (((((r15) + 4) >> 3) & 1) * (F8 ? 2 : 1)))
    unsigned voffA[2], voffB[2];
#pragma unroll
    for (int i = 0; i < 2; ++i) {
        if constexpr (FL) { const int q = tid + 512 * i, R = 8 * (q >> 6) + ((q >> 3) & 7), Cb = 16 * ((q & 7) ^ PG8_FSW(R & 15)); const int Rb = Epi::PERM ? ((R & ~31) + perm32(R & 31)) : R;
            voffA[i] = (unsigned)(R * KB + Cb); voffB[i] = (unsigned)(Rb * KB + Cb); }
        else if constexpr (F8) { const int q = tid + 512 * i, R = 16 * (q >> 7) + (q & 15), Cb = 16 * ((q >> 4) & 7); const int Rb = Epi::PERM ? ((R & ~31) + perm32(R & 31)) : R;
            voffA[i] = (unsigned)(R * KB + Cb); voffB[i] = (unsigned)(Rb * KB + Cb); }
        else { int R, C; stage_rc(tid * 16 + i * 8192, R, C); const int Rb = Epi::PERM ? ((R & ~31) + perm32(R & 31)) : R;
            voffA[i] = (unsigned)(R * K + C) * 2u; voffB[i] = (unsigned)(Rb * K + C) * 2u; } }
    const size_t kstep = (size_t)128;
    const size_t hstep = (size_t)HALF * KB;
    const size_t tstep = 2 * hstep;
    const unsigned ldsw = (unsigned)wid * 1024u;
    int aoffk[2], boffk[2];
#pragma unroll
    for (int k = 0; k < 2; ++k) {
        if constexpr (FL) { const int cs = F8 ? 2 * fq + k : fq + 4 * k, c = cs ^ PG8_FSW(fr); aoffk[k] = (wr * 64 + fr) * 128 + c * 16; boffk[k] = (wc * 32 + fr) * 128 + c * 16; }
        else if constexpr (F8) { aoffk[k] = (wr * 4) * 2048 + (2 * fq + k) * 256 + fr * 16; boffk[k] = (wc * 2) * 2048 + (2 * fq + k) * 256 + fr * 16; }
        else { aoffk[k] = lds_byte(wr * 64 + fr, fq * 8) + k * 1024; boffk[k] = lds_byte(wc * 32 + fr, fq * 8) + k * 1024; } }
    const int sc1 = 0x7F7F7F7F;
    unsigned cG0[2] = {0u, 0u}, cG1[2] = {0u, 0u};
    int nui = 0;
#define PG8_GOFS1(ui_, h, o) do { _Pragma("unroll") for (int _i = 0; _i < 2; ++_i) { int R_, Cb_; \
        if constexpr (FL) { const int q_ = tid + 512 * _i; R_ = 8 * (q_ >> 6) + ((q_ >> 3) & 7); Cb_ = 16 * ((q_ & 7) ^ PG8_FSW(R_ & 15)); } \
        else if constexpr (F8) { const int q_ = tid + 512 * _i; R_ = 16 * (q_ >> 7) + (q_ & 15); Cb_ = 16 * ((q_ >> 4) & 7); } else { int C_; stage_rc(tid * 16 + _i * 8192, R_, C_); Cb_ = 2 * C_; } \
        (o)[_i] = (unsigned)rtab[(ui_) * 256 + (h) * 128 + R_] * (unsigned)KB + (unsigned)Cb_; } } while (0)
#define PG8_STAGE_A(bufoff, gbase, h, nx) do { if constexpr (GATHER) { if (nx) { unsigned vo_[2]; PG8_GOFS1(nui, h, vo_); PG8_STAGE(bufoff, gbase, vo_); } else { if (h) PG8_STAGE(bufoff, gbase, cG1); else PG8_STAGE(bufoff, gbase, cG0); } } \
        else { PG8_STAGE(bufoff, (gbase) + (h) * hstep, voffA); } } while (0)
    unsigned pfd = 0u; const unsigned pfoff = (unsigned)((tid & 255) * KB);
    const char* nA = nullptr; const char* nB = nullptr;
#define PG8_PF(tt_) do { if constexpr (PF) { const int tt__ = (tt_); const bool nx__ = tt__ >= nt; const int tk__ = nx__ ? tt__ - nt : tt__; \
        const char* pb__ = (wid < 4) ? ((nx__ ? nA : cA) + (size_t)tk__ * kstep) : ((nx__ ? nB : cB) + (size_t)tk__ * kstep); unsigned vo__ = pfoff; \
        if constexpr (GATHER) { if (wid < 4) vo__ = (unsigned)rtab[(nx__ ? nui : ui) * 256 + tid] * (unsigned)KB; } \
        asm volatile("global_load_dword %0, %1, %2" : "+v"(pfd) : "v"(vo__), "s"(pb__) : "memory"); } } while (0)
#define PG8_SA(b, h) (((b) * 2 + (h)) * HTB)
#define PG8_SB(b, h) ((4 + (b) * 2 + (h)) * HTB)
    const unsigned ldsbase = (unsigned)__builtin_amdgcn_readfirstlane((int)((unsigned)(size_t)lds + ldsw));
#define PG8_STAGE(bufoff, gbase, voff) do { _Pragma("unroll") for (int _i = 0; _i < 2; ++_i) glds16((const char*)(gbase), (voff)[_i], ldsbase + (unsigned)((bufoff) + _i * 8192)); } while (0)
#define PG8_LDA(dst, b, h) do { _Pragma("unroll") for (int m = 0; m < 4; ++m) _Pragma("unroll") for (int k = 0; k < 2; ++k) dst[m][k] = *(const PG8_LAS bf16x8*)(lds + PG8_SA(b, h) + aoffk[k] + m * 2048); } while (0)
#define PG8_LDB(dst, b, h) do { _Pragma("unroll") for (int n = 0; n < 2; ++n) _Pragma("unroll") for (int k = 0; k < 2; ++k) dst[n][k] = *(const PG8_LAS bf16x8*)(lds + PG8_SB(b, h) + boffk[k] + n * 2048); } while (0)
#define PG8_CAT(v) __builtin_shufflevector(__builtin_bit_cast(i32x4, (v)[0]), __builtin_bit_cast(i32x4, (v)[1]), 0, 1, 2, 3, 4, 5, 6, 7)
#define PG8_MMA(ai, bj, At, Bt) do { __builtin_amdgcn_s_setprio(1); if constexpr (F8) { _Pragma("unroll") for (int m = 0; m < 4; ++m) _Pragma("unroll") for (int n = 0; n < 2; ++n) { \
        const i32x8 a8_ = PG8_CAT(Bt[n]), b8_ = PG8_CAT(At[m]); asm volatile("v_mfma_scale_f32_16x16x128_f8f6f4 %0, %1, %2, %0, %3, %3 op_sel_hi:[0,0,0]" : "+v"(acc[ai][bj][m][n]) : "v"(a8_), "v"(b8_), "v"(sc1)); } } \
        else { _Pragma("unroll") for (int m = 0; m < 4; ++m) _Pragma("unroll") for (int n = 0; n < 2; ++n) _Pragma("unroll") for (int k = 0; k < 2; ++k) \
        acc[ai][bj][m][n] = __builtin_amdgcn_mfma_f32_16x16x32_bf16(Bt[n][k], At[m][k], acc[ai][bj][m][n], 0, 0, 0); } __builtin_amdgcn_s_setprio(0); } while (0)
#define PG8_WAIT_V(n) asm volatile("s_waitcnt vmcnt(" #n ")" ::: "memory")
#define PG8_WAIT_L(n) asm volatile("s_waitcnt lgkmcnt(" #n ")" ::: "memory")
#define PG8_BAR __builtin_amdgcn_s_barrier()
#define PG8_SCHED __builtin_amdgcn_sched_barrier(0)
    const unsigned lbias = (unsigned)__builtin_amdgcn_readfirstlane((int)((unsigned)(size_t)lds + (unsigned)BIAS_LDS_OFF + (unsigned)wid * 256u));
    const PG8_LAS float* lb = (const PG8_LAS float*)(lds + BIAS_LDS_OFF + wid * 256);
    const unsigned voffbias = (unsigned)(((lane >> 5) * HALF + wc * 32 + (lane & 31)) * 4);
    const unsigned lposa = (unsigned)__builtin_amdgcn_readfirstlane((int)((unsigned)(size_t)lds + (unsigned)POS_LDS_OFF + (unsigned)wid * 512u));
    const PG8_LAS int* lp = (const PG8_LAS int*)(lds + POS_LDS_OFF + wid * 512);
#define PG8_UNIT_DMA(u_, ui_) do { glds4((const char*)E.bias_seg(u_, ui_), voffbias, lbias); \
        if constexpr (Epi::NEED_POS) { const char* pp_ = (const char*)(E.pos + (u_).pm * BM + wr * 64); glds4(pp_, (unsigned)lane * 4u, lposa); glds4(pp_ + 512, (unsigned)lane * 4u, lposa + 256u); } } while (0)
    Unit cur, nxt; int ui = 0;
    if (!S.next(0, cur)) return;
    PG8_UNIT_DMA(cur, 0);
    f32x4 acc[2][2][4][2];
#pragma unroll
    for (int a = 0; a < 2; ++a)
#pragma unroll
        for (int b = 0; b < 2; ++b)
#pragma unroll
            for (int m = 0; m < 4; ++m)
#pragma unroll
                for (int n = 0; n < 2; ++n) acc[a][b][m][n] = (f32x4){0.f, 0.f, 0.f, 0.f};
    bf16x8 At[4][2], B0[2][2], B1[2][2];
    const char* cA = GATHER ? (const char*)g.A : (const char*)g.A + (size_t)cur.pm * tstep; const char* cB = b_tile_ptr(g, cur, tstep, 0);
    if constexpr (GATHER) { PG8_GOFS1(0, 0, cG0); PG8_GOFS1(0, 1, cG1); }
    S.a_ready(cur);
    if constexpr (SP2) {
        PG8_STAGE(PG8_SB(0, 0), cB, voffB); PG8_STAGE(PG8_SB(0, 1), cB + hstep, voffB); PG8_STAGE_A(PG8_SA(0, 0), cA, 0, false); PG8_STAGE_A(PG8_SA(0, 1), cA, 1, false);
        if (wr == 1) PG8_BAR;
        PG8_WAIT_V(2); PG8_BAR;
        PG8_STAGE(PG8_SB(1, 0), cB + kstep, voffB); PG8_STAGE_A(PG8_SA(1, 0), cA + kstep, 0, false); PG8_STAGE(PG8_SB(1, 1), cB + hstep + kstep, voffB);
        PG8_WAIT_V(6); PG8_BAR;
        if constexpr (PF) { nA = cA; nB = cB; PG8_PF(2); }
    } else {
        PG8_STAGE(PG8_SB(0, 0), cB, voffB); PG8_STAGE(PG8_SA(0, 0), cA, voffA); PG8_STAGE(PG8_SB(0, 1), cB + hstep, voffB); PG8_STAGE(PG8_SA(0, 1), cA + hstep, voffA);
        if (wr == 1) PG8_BAR;
        PG8_WAIT_V(4); PG8_BAR;
        PG8_STAGE(PG8_SB(1, 0), cB + kstep, voffB); PG8_STAGE(PG8_SA(1, 0), cA + kstep, voffA); PG8_STAGE(PG8_SB(1, 1), cB + hstep + kstep, voffB);
        PG8_WAIT_V(6); PG8_BAR;
    }
    for (;;) {
        const bool has_next = S.next(ui + 1, nxt);
        nA = GATHER ? cA : (has_next ? (const char*)g.A + (size_t)nxt.pm * tstep : cA); nB = has_next ? b_tile_ptr(g, nxt, tstep, ui + 1) : cB;
        if constexpr (GATHER) nui = has_next ? ui + 1 : ui;
#pragma unroll 1
        for (int t = 0; t < nt; t += 2) {
            const bool last = (t == nt - 2);
            const char* a1 = cA + (size_t)(t + 1) * kstep;
            const char* a2 = last ? nA : cA + (size_t)(t + 2) * kstep; const char* b2 = last ? nB : cB + (size_t)(t + 2) * kstep;
            const char* a3 = a2 + kstep; const char* b3 = b2 + kstep;
            if (last && has_next) S.a_ready(nxt);
            if constexpr (SP2) {
            PG8_LDB(B0, 0, 0); PG8_LDB(B1, 0, 1); PG8_SCHED; PG8_LDA(At, 0, 0); PG8_STAGE_A(PG8_SA(1, 1), a1, 1, false);
            if constexpr (PF) PG8_WAIT_V(9); else PG8_WAIT_V(8);
            PG8_WAIT_L(0); PG8_BAR; PG8_MMA(0, 0, At, B0); PG8_MMA(0, 1, At, B1); PG8_BAR; PG8_SCHED;
            PG8_LDA(At, 0, 1); PG8_STAGE(PG8_SB(0, 0), b2, voffB); PG8_STAGE(PG8_SB(0, 1), b2 + hstep, voffB); PG8_STAGE_A(PG8_SA(0, 0), a2, 0, last); PG8_PF(t + 4);
            if constexpr (PF) PG8_WAIT_V(10); else PG8_WAIT_V(8);
            PG8_WAIT_L(0); PG8_BAR; PG8_MMA(1, 0, At, B0); PG8_MMA(1, 1, At, B1); PG8_BAR; PG8_SCHED;
            PG8_LDB(B0, 1, 0); PG8_LDB(B1, 1, 1); PG8_SCHED; PG8_LDA(At, 1, 0); PG8_STAGE_A(PG8_SA(0, 1), a2, 1, last);
            if constexpr (PF) PG8_WAIT_V(9); else PG8_WAIT_V(8);
            PG8_WAIT_L(0); PG8_BAR; PG8_MMA(0, 0, At, B0); PG8_MMA(0, 1, At, B1); PG8_BAR; PG8_SCHED;
            PG8_LDA(At, 1, 1); PG8_STAGE(PG8_SB(1, 0), b3, voffB); PG8_STAGE(PG8_SB(1, 1), b3 + hstep, voffB); PG8_STAGE_A(PG8_SA(1, 0), a3, 0, last); PG8_PF(t + 5);
            if constexpr (PF) PG8_WAIT_V(10); else PG8_WAIT_V(8);
            PG8_WAIT_L(0); PG8_BAR; PG8_MMA(1, 0, At, B0); PG8_MMA(1, 1, At, B1); PG8_BAR; PG8_SCHED;
            } else {
            static_assert(SP2 || !GATHER, "GATHER is implemented for the SP2 loop only");
            PG8_LDB(B0, 0, 0); PG8_SCHED; PG8_LDA(At, 0, 0); PG8_STAGE(PG8_SA(1, 1), a1 + hstep, voffA);
            PG8_WAIT_L(8); PG8_BAR; PG8_WAIT_L(0); PG8_MMA(0, 0, At, B0); PG8_BAR; PG8_SCHED;
            PG8_LDB(B1, 0, 1); PG8_STAGE(PG8_SB(0, 0), b2, voffB);
            PG8_BAR; PG8_WAIT_L(0); PG8_MMA(0, 1, At, B1); PG8_BAR;
            PG8_LDA(At, 0, 1); PG8_STAGE(PG8_SA(0, 0), a2, voffA);
            PG8_BAR; PG8_WAIT_L(0); PG8_MMA(1, 0, At, B0); PG8_BAR; PG8_SCHED;
            PG8_STAGE(PG8_SB(0, 1), b2 + hstep, voffB);
            PG8_WAIT_V(6); PG8_BAR; PG8_MMA(1, 1, At, B1); PG8_BAR;
            PG8_LDB(B0, 1, 0); PG8_SCHED; PG8_LDA(At, 1, 0); PG8_STAGE(PG8_SA(0, 1), a2 + hstep, voffA);
            PG8_WAIT_L(8); PG8_BAR; PG8_WAIT_L(0); PG8_MMA(0, 0, At, B0); PG8_BAR; PG8_SCHED;
            PG8_LDB(B1, 1, 1); PG8_STAGE(PG8_SB(1, 0), b3, voffB);
            PG8_BAR; PG8_WAIT_L(0); PG8_MMA(0, 1, At, B1); PG8_BAR;
            PG8_LDA(At, 1, 1); PG8_STAGE(PG8_SA(1, 0), a3, voffA);
            PG8_BAR; PG8_WAIT_L(0); PG8_MMA(1, 0, At, B0); PG8_BAR; PG8_SCHED;
            PG8_STAGE(PG8_SB(1, 1), b3 + hstep, voffB);
            PG8_WAIT_V(6); PG8_BAR; PG8_MMA(1, 1, At, B1); PG8_BAR;
            }
        }
        if constexpr (ALIGN_EPI) { if (wr == 0) PG8_BAR; }
        if constexpr (F8) asm volatile("s_nop 15\n\ts_nop 15" ::: "memory");
        if constexpr (!Epi::AFTER_DRAIN) { E(acc, cur, wr, wc, fr, fq, lb, lp); S.done(cur); }
        if (!has_next) break;
#pragma unroll
        for (int a = 0; a < 2; ++a)
#pragma unroll
            for (int b = 0; b < 2; ++b)
#pragma unroll
                for (int m = 0; m < 4; ++m)
#pragma unroll
                    for (int n = 0; n < 2; ++n) acc[a][b][m][n] = (f32x4){0.f, 0.f, 0.f, 0.f};
        cur = nxt; cA = nA; cB = nB; ++ui;
        asm volatile("s_waitcnt lgkmcnt(0)" ::: "memory");
        PG8_UNIT_DMA(cur, ui);
        if constexpr (GATHER) { PG8_GOFS1(ui, 0, cG0); PG8_GOFS1(ui, 1, cG1); }
        if constexpr (ALIGN_EPI) { if (wr == 1) PG8_BAR; }
    }
    PG8_WAIT_V(0);
    asm volatile("" :: "v"(pfd));
    if constexpr (!ALIGN_EPI) { if (wr == 0) PG8_BAR; }
    PG8_BAR;
#undef PG8_UNIT_DMA
#undef PG8_SA
#undef PG8_SB
#undef PG8_FSW
#undef PG8_PF
#undef PG8_STAGE_A
#undef PG8_GOFS1
#undef PG8_STAGE
#undef PG8_LDA
#undef PG8_LDB
#undef PG8_MMA
#undef PG8_CAT
#undef PG8_WAIT_V
#undef PG8_WAIT_L
#undef PG8_BAR
#undef PG8_SCHED
}
}

constexpr int BATCH = 32, SEQ = 2048, D = 1024, T = BATCH * SEQ;
constexpr int INW = 5632, NE = 32, NHQ = 16, HD = 64;
constexpr int C_K = 1024, C_V = 1280, C_LX = 1536, C_LY = 2560, C_GA = 3584, C_GL = 4608;
constexpr float EPS = 1e-6f, LOG2E = 1.4426950408889634f;
constexpr int HALF_T = T / 2, NGRP = T / 256, GRP_H = NGRP / 2;
constexpr int MAXBLK = T * 4 / 256 + NE;

constexpr size_t MiB = 1u << 20;
constexpr size_t WS_CTL = 0, CTL_ZERO_BYTES = 1 * MiB;
constexpr size_t WS_MOD = 1 * MiB;
constexpr size_t WS_BINP = 2 * MiB, WS_LC = 2 * MiB + 32768, WS_WRT = 2 * MiB + 65536, WS_BE1P = 2 * MiB + 262144;
constexpr size_t WS_WRGT = 3 * MiB, WS_WIGT = 3 * MiB + 262144;
constexpr size_t WS_CNT = 4 * MiB, WS_NBLK = 4 * MiB + 65536, WS_BLKE = 4 * MiB + 131072;
constexpr size_t WS_TKI = 5 * MiB, WS_TKW = 6 * MiB, WS_TKP = 7 * MiB, WS_SLOT = 8 * MiB;
constexpr size_t WS_LP = 10 * MiB, WS_LH = 12 * MiB;
constexpr size_t WS_ROWTOK = 14 * MiB;
constexpr size_t WS_CS = 16 * MiB;
constexpr size_t WS_WBIN = 32 * MiB, WS_WBOUT = 44 * MiB;
constexpr size_t WS_H = 48 * MiB;
constexpr size_t WS_PROJ = 176 * MiB;
constexpr size_t WS_MRG = 880 * MiB;
constexpr size_t WS_Y1 = 600 * MiB;
constexpr size_t WS_WBE1 = 112 * MiB, WS_WBE2 = 176 * MiB;
constexpr size_t WS_ACT = 208 * MiB;
constexpr size_t WS_YP = 472 * MiB, WS_END = 1000 * MiB;
static_assert(WS_PROJ + (size_t)T * INW * 2 <= 1024 * MiB, "proj fits");
static_assert(WS_H + (size_t)T * D <= WS_WBE1 && WS_WBE1 + (size_t)NE * 2048 * D <= WS_WBE2 && WS_WBE2 + (size_t)NE * D * D <= WS_ACT && WS_ACT + (size_t)MAXBLK * 256 * 1024 <= WS_YP && WS_YP + (size_t)MAXBLK * 256 * 2048 <= WS_END, "moe buffers");
static_assert(WS_Y1 >= WS_ACT && WS_Y1 + (size_t)T * D * 2 <= WS_MRG, "y1 (P5 -> P6) clear of the buffers P6 writes");
constexpr int CW_BAR = 4096;

constexpr int RING_BYTES = 131072, LDSCTL_OFF = RING_BYTES, LDS_BYTES = 163840, RTAB_OFF = LDSCTL_OFF + 12288, RTAB_UNITS = 34, ETAB_OFF = LDSCTL_OFF + 5120, ETAB_UNITS = 64, UTAB_OFF = LDSCTL_OFF + 5376, UTAB_UNITS = 64;
constexpr int NWAVES = 8;

typedef unsigned short bf16;
typedef unsigned v4u __attribute__((ext_vector_type(4)));
typedef unsigned v2u __attribute__((ext_vector_type(2)));
typedef float f32x4 __attribute__((ext_vector_type(4)));
typedef float f32x16 __attribute__((ext_vector_type(16)));
typedef float f32x2 __attribute__((ext_vector_type(2)));
typedef short bf16x8 __attribute__((ext_vector_type(8)));
typedef unsigned u32x4v __attribute__((ext_vector_type(4)));
typedef __bf16 bf16x2v __attribute__((ext_vector_type(2)));
__device__ __forceinline__ unsigned pkbf(float lo, float hi) { const f32x2 v = {lo, hi}; return __builtin_bit_cast(unsigned, __builtin_convertvector(v, bf16x2v)); }
#define LDS_WAIT() asm volatile("s_waitcnt lgkmcnt(0)" ::: "memory")
#define LDS_BARRIER() do { asm volatile("s_waitcnt lgkmcnt(0)" ::: "memory"); __builtin_amdgcn_s_barrier(); asm volatile("" ::: "memory"); } while (0)
__device__ __forceinline__ unsigned f2bf(float f) { unsigned u = __builtin_bit_cast(unsigned, f); return (u + 0x7fffu + ((u >> 16) & 1u)) >> 16; }
__device__ __forceinline__ unsigned pk2(float lo, float hi) { return f2bf(lo) | (f2bf(hi) << 16); }
__device__ __forceinline__ float bflo(unsigned w) { return __uint_as_float(w << 16); }
__device__ __forceinline__ float bfhi(unsigned w) { return __uint_as_float(w & 0xffff0000u); }
__device__ __forceinline__ float bf1(bf16 h) { return __uint_as_float((unsigned)h << 16); }
__device__ __forceinline__ int ld_agent(const int* p) { return (int)__hip_atomic_load((unsigned*)p, __ATOMIC_RELAXED, __HIP_MEMORY_SCOPE_AGENT); }
template <int CTRL> __device__ __forceinline__ float dpp_add(float v) { const int t = __builtin_amdgcn_update_dpp(0, __float_as_int(v), CTRL, 0xf, 0xf, true); return v + __int_as_float(t); }
__device__ __forceinline__ float wave_sum(float v) {
    v = dpp_add<0xB1>(v); v = dpp_add<0x4E>(v); v = dpp_add<0x141>(v); v = dpp_add<0x140>(v);
    const int iv = __float_as_int(v);
    return (__int_as_float(__builtin_amdgcn_readlane(iv, 0)) + __int_as_float(__builtin_amdgcn_readlane(iv, 16))) + (__int_as_float(__builtin_amdgcn_readlane(iv, 32)) + __int_as_float(__builtin_amdgcn_readlane(iv, 48)));
}

#define XB_TMO      128
#define XB_XCNT(j)  (256  + 64 * (j))
#define XB_XSUB(j)  (1280 + 64 * (j))
#define XB_XGEN(j)  (2304 + 64 * (j))
#define XB_TOP      3328
#define XB_TOPGEN   3392
#define XCD_BAR_WORDS 3456
#define XB_SPIN_CAP (1u << 18)
__device__ __forceinline__ unsigned xb_ld(unsigned* p)              { return __hip_atomic_load(p, __ATOMIC_RELAXED, __HIP_MEMORY_SCOPE_AGENT); }
__device__ __forceinline__ unsigned xb_add(unsigned* p, unsigned v) { return __hip_atomic_fetch_add(p, v, __ATOMIC_RELAXED, __HIP_MEMORY_SCOPE_AGENT); }
__device__ __forceinline__ unsigned xb_xcc_id() { return (unsigned)__builtin_amdgcn_s_getreg((3 << 11) | 20) & 0xFu; }
#define XB_SPIN(cond, bar) do { unsigned _sp = 0; while (cond) { __builtin_amdgcn_s_sleep(1); \
    if ((++_sp & 255u) == 0u) { if (xb_ld(&(bar)[XB_TMO])) break; if (_sp > XB_SPIN_CAP) { atomicAdd(&(bar)[XB_TMO], 1u); break; } } } } while (0)
struct XcdBarrier { unsigned* bar; unsigned x; volatile LAS unsigned* st; };
__device__ __forceinline__ XcdBarrier xcd_barrier_post(unsigned* bar, volatile LAS unsigned* st) {
    XcdBarrier b; b.bar = bar; b.x = xb_xcc_id(); b.st = st;
    if (threadIdx.x == 0) (void)xb_add(&bar[XB_XCNT(b.x)], 1u);
    return b;
}
__device__ __forceinline__ void xcd_barrier_complete(unsigned* bar, unsigned x, unsigned& nloc, unsigned& nx) {
    const unsigned G = gridDim.x * gridDim.y * gridDim.z;
    unsigned sum, cnt, mine, sp = 0u;
    for (;;) {
        sum = 0u; cnt = 0u; mine = 0u;
#pragma unroll
        for (unsigned j = 0; j < 16; ++j) { const unsigned c = xb_ld(&bar[XB_XCNT(j)]); sum += c; cnt += (c > 0u) ? 1u : 0u; mine = (j == x) ? c : mine; }
        if (sum == G) break;
        __builtin_amdgcn_s_sleep(1);
        if ((++sp & 255u) == 0u) { if (xb_ld(&bar[XB_TMO])) break; if (sp > XB_SPIN_CAP) { atomicAdd(&bar[XB_TMO], 1u); break; } }
    }
    nloc = mine > 0u ? mine : 1u; nx = cnt > 0u ? cnt : 1u;
}
__device__ __forceinline__ void xcd_barrier(const XcdBarrier& b) {
    asm volatile("s_waitcnt vmcnt(0)" ::: "memory");
    __syncthreads();
    if (threadIdx.x == 0) {
        unsigned* bar = b.bar;
        __builtin_amdgcn_s_waitcnt(0);
        unsigned nloc = b.st[0], nx = b.st[1];
        if (nloc == 0u) { xcd_barrier_complete(bar, b.x, nloc, nx); b.st[0] = nloc; b.st[1] = nx; }
        const unsigned old = xb_add(&bar[XB_XSUB(b.x)], 1u);
        const unsigned gen = old / nloc;
        if (old + 1u == (gen + 1u) * nloc) {
            __builtin_amdgcn_fence(__ATOMIC_RELEASE, "agent");
            asm volatile("s_waitcnt vmcnt(0)" ::: "memory");
            const unsigned og = xb_add(&bar[XB_TOP], 1u);
            const unsigned tg = og / nx;
            if (og + 1u == (tg + 1u) * nx) xb_add(&bar[XB_TOPGEN], 1u);
            else XB_SPIN(xb_ld(&bar[XB_TOPGEN]) == tg, bar);
            __builtin_amdgcn_fence(__ATOMIC_ACQUIRE, "agent");
            xb_add(&bar[XB_XGEN(b.x)], 1u);
            asm volatile("s_waitcnt vmcnt(0)" ::: "memory");
        } else {
            XB_SPIN(xb_ld(&bar[XB_XGEN(b.x)]) == gen, bar);
            __builtin_amdgcn_fence(__ATOMIC_ACQUIRE, "agent");
            asm volatile("s_waitcnt vmcnt(0)" ::: "memory");
        }
    }
    __syncthreads();
}

__device__ __forceinline__ int rowmap_in(int c) {
    if (c < C_V) { const int w = c & 63; return (c & ~63) + 2 * (w & 31) + (w >> 5); }
    if (c >= C_LY && c < C_GA) { const int ch = c - C_LY, j = ch >> 7, pn = j < 4 ? 10 + j : 14 + j; return 256 * pn + (ch & 127); }
    if (c >= C_GL) { const int ch = c - C_GL, j = ch >> 7, pn = j < 4 ? 10 + j : 14 + j; return 256 * pn + 128 + (ch & 127); }
    return c; }
__device__ __forceinline__ int rowmap_e1(int c) { const int cc = c & 1023; return 256 * (cc >> 7) + (cc & 127) + ((c >> 10) << 7); }
template <int MAP>
__device__ __forceinline__ void transpose_item(const float* W, int K, int N, bf16* WT, LAS float* scr, int item, int lane) {
    const int nblk = N / 32, kb = item / nblk, nb = item % nblk, k0 = 64 * kb, n0 = 32 * nb;
    float tv_[32];
#pragma unroll
    for (int i = 0; i < 32; ++i) tv_[i] = W[(size_t)(k0 + 2 * i + (lane >> 5)) * N + n0 + (lane & 31)];
#pragma unroll
    for (int i = 0; i < 32; ++i) scr[(2 * i + (lane >> 5)) * 33 + (lane & 31)] = tv_[i];
    LDS_WAIT(); asm volatile("" ::: "memory");
    const int c = lane & 7;
#pragma unroll
    for (int j = 0; j < 4; ++j) { const int n = (lane >> 3) + 8 * j; const LAS float* s = scr + (8 * c) * 33 + n;
        v4u o; o.x = pk2(s[0 * 33], s[1 * 33]); o.y = pk2(s[2 * 33], s[3 * 33]); o.z = pk2(s[4 * 33], s[5 * 33]); o.w = pk2(s[6 * 33], s[7 * 33]);
        const int nn = n0 + n; const int row = MAP == 1 ? rowmap_in(nn) : (MAP == 2 ? rowmap_e1(nn) : nn);
        *(GAS v4u*)(WT + (size_t)row * K + k0 + 8 * c) = o; }
    LDS_WAIT(); asm volatile("" ::: "memory");
}

template <int MAP>
__device__ __forceinline__ void transpose_item8(const float* W, int K, int N, unsigned char* WT, LAS float* scr, int item, int lane) {
    const int nblk = N / 32, kb = item / nblk, nb = item % nblk, k0 = 64 * kb, n0 = 32 * nb;
    float tv_[32];
#pragma unroll
    for (int i = 0; i < 32; ++i) tv_[i] = W[(size_t)(k0 + 2 * i + (lane >> 5)) * N + n0 + (lane & 31)];
#pragma unroll
    for (int i = 0; i < 32; ++i) scr[(2 * i + (lane >> 5)) * 33 + (lane & 31)] = tv_[i];
    LDS_WAIT(); asm volatile("" ::: "memory");
    const int c = lane & 7;
#pragma unroll
    for (int j = 0; j < 4; ++j) { const int n = (lane >> 3) + 8 * j; const LAS float* sp = scr + (8 * c) * 33 + n;
        v2u o; o.x = pg8::pk4_fp8(sp[0 * 33] * pg8::W8_SCALE, sp[1 * 33] * pg8::W8_SCALE, sp[2 * 33] * pg8::W8_SCALE, sp[3 * 33] * pg8::W8_SCALE);
        o.y = pg8::pk4_fp8(sp[4 * 33] * pg8::W8_SCALE, sp[5 * 33] * pg8::W8_SCALE, sp[6 * 33] * pg8::W8_SCALE, sp[7 * 33] * pg8::W8_SCALE);
        const int nn = n0 + n; const int row = MAP == 2 ? rowmap_e1(nn) : nn;
        *(GAS v2u*)(WT + (size_t)row * K + k0 + 8 * c) = o; }
    LDS_WAIT(); asm volatile("" ::: "memory");
}

struct Args { const void* in[27]; float* out; unsigned char* ws; int ph_lo, ph_hi; };

__global__ void __launch_bounds__(NWAVES * 64, 2) fwd(Args args) {
    extern __shared__ __attribute__((aligned(16))) unsigned char lds[];
    LAS unsigned char* ldsb = (LAS unsigned char*)lds;
    volatile LAS unsigned* MISC = (volatile LAS unsigned*)(ldsb + LDSCTL_OFF);
    const int tid = threadIdx.x, lane = tid & 63, wave = __builtin_amdgcn_readfirstlane(tid >> 6);
    const int G = gridDim.x, bx = blockIdx.x;
    const int gw = bx * NWAVES + wave, NGW = G * NWAVES;
    unsigned char* ws = args.ws;
    unsigned* ctl = (unsigned*)(ws + WS_CTL);
#define x_in ((const float*)args.in[0])
#define cvec ((const float*)args.in[1])
#define positions ((const int*)args.in[2])
#define w_ada ((const float*)args.in[3])
#define b_ada ((const float*)args.in[4])
#define g_pre_mix ((const float*)args.in[5])
#define g_post_mix ((const float*)args.in[6])
#define w_in ((const float*)args.in[7])
#define b_in ((const float*)args.in[8])
#define sinks ((const float*)args.in[9])
#define conv_w ((const float*)args.in[10])
#define conv_b ((const float*)args.in[11])
#define w_rg ((const float*)args.in[12])
#define b_rg ((const float*)args.in[13])
#define w_ig ((const float*)args.in[14])
#define b_ig ((const float*)args.in[15])
#define lru_a ((const float*)args.in[16])
#define w_out ((const float*)args.in[17])
#define b_out ((const float*)args.in[18])
#define g_pre_ffn ((const float*)args.in[19])
#define g_post_ffn ((const float*)args.in[20])
#define w_router ((const float*)args.in[21])
#define b_router ((const float*)args.in[22])
#define w_e1 ((const float*)args.in[23])
#define b_e1 ((const float*)args.in[24])
#define w_e2 ((const float*)args.in[25])
#define b_e2 ((const float*)args.in[26])
#define out (args.out)
#define MOD ((float*)(args.ws + WS_MOD))
#define BINP ((float*)(args.ws + WS_BINP))
#define LC ((float*)(args.ws + WS_LC))
#define WRT ((float*)(args.ws + WS_WRT))
#define BE1P ((float*)(args.ws + WS_BE1P))
#define WRGT ((bf16*)(args.ws + WS_WRGT))
#define WIGT ((bf16*)(args.ws + WS_WIGT))
#define CNT ((int*)(args.ws + WS_CNT))
#define NBLK ((int*)(args.ws + WS_NBLK))
#define BLKE ((int*)(args.ws + WS_BLKE))
#define TKI ((int*)(args.ws + WS_TKI))
#define TKW ((float*)(args.ws + WS_TKW))
#define TKP ((int*)(args.ws + WS_TKP))
#define SLOT ((int*)(args.ws + WS_SLOT))
#define ROWTOK ((unsigned short*)(args.ws + WS_ROWTOK))
#define LP ((float*)(args.ws + WS_LP))
#define LH ((float*)(args.ws + WS_LH))
#define CS ((float*)(args.ws + WS_CS))
#define WBIN ((bf16*)(args.ws + WS_WBIN))
#define WBOUT ((bf16*)(args.ws + WS_WBOUT))
#define HB ((bf16*)(args.ws + WS_H))
#define PROJ ((bf16*)(args.ws + WS_PROJ))
#define MRG ((bf16*)(args.ws + WS_MRG))
#define Y1 ((bf16*)(args.ws + WS_Y1))
#define WBE1 ((unsigned char*)(args.ws + WS_WBE1))
#define WBE2 ((unsigned char*)(args.ws + WS_WBE2))
#define ACT ((unsigned char*)(args.ws + WS_ACT))
#define YP ((unsigned char*)(args.ws + WS_YP))
#define H8 ((unsigned char*)(args.ws + WS_H))

    for (int u = tid; u < (LDS_BYTES - LDSCTL_OFF) / 4; u += NWAVES * 64) ((LAS unsigned*)(ldsb + LDSCTL_OFF))[u] = 0u;
    __syncthreads();
    XcdBarrier bar; bar.bar = ctl + CW_BAR; bar.x = 0; bar.st = nullptr;
    if (MK_N_LAUNCHES == 1) bar = xcd_barrier_post(ctl + CW_BAR, MISC);
    const int lo = args.ph_lo, hi = args.ph_hi;
#define IN(k) (lo <= (k) && (k) < hi)
#define SEAM(k) do { if (IN(k) && IN((k) + 1)) xcd_barrier(bar); } while (0)
#ifndef LRU_STOP
#define LRU_STOP 0
#endif
#ifndef GEMM_PF
#define GEMM_PF false
#endif
#ifndef DBL_MASK
#define DBL_MASK 0
#endif
#define REP(k) _Pragma("unroll") for (int rep_ = 0; rep_ < 1 + ((DBL_MASK >> (k)) & 1); ++rep_)
#define REPBAR() do { if (rep_) xcd_barrier(bar); } while (0)

    REP(0) { REPBAR();
    if (IN(0)) {
        constexpr int NGV = 192;
        for (int cb = bx; cb < NGV; cb += G) {
            LAS float* sck = (LAS float*)ldsb;
            LAS float* red = (LAS float*)(ldsb + LDSCTL_OFF + 1024);
#pragma unroll 1
            for (int j0 = 0; j0 < 64; j0 += 32) {
                float cv[32];
#pragma unroll
                for (int j = 0; j < 32; ++j) cv[j] = cvec[tid + 512 * (j0 + j)];
#pragma unroll
                for (int j = 0; j < 32; ++j) { const int i = tid + 512 * (j0 + j), b = i >> 10, k = i & 1023; const float v = cv[j];
                    sck[k * 32 + ((((b >> 2) ^ (k & 7)) << 2) | (b & 3))] = v * __builtin_amdgcn_rcpf(1.0f + __builtin_amdgcn_exp2f(-1.4426950408889634f * v)); }
            }
            __syncthreads();
            const int h = lane >> 5, nl = lane & 31, n = cb * 32 + nl, kbase = wave * 128 + h * 64;
            float acc[32];
#pragma unroll
            for (int b = 0; b < 32; ++b) acc[b] = 0.f;
            float wv0[32], wv1[32];
#pragma unroll
            for (int kk = 0; kk < 32; ++kk) wv0[kk] = w_ada[(size_t)(kbase + kk) * 6144 + n];
#pragma unroll
            for (int kk = 0; kk < 32; ++kk) wv1[kk] = w_ada[(size_t)(kbase + 32 + kk) * 6144 + n];
            const LAS float* sp = sck + kbase * 32;
#pragma unroll
            for (int kk = 0; kk < 32; ++kk) { const float w = wv0[kk];
#pragma unroll
                for (int b4 = 0; b4 < 8; ++b4) { const f32x4 sv = *(const LAS f32x4*)(sp + kk * 32 + 4 * (b4 ^ (kk & 7)));
                    acc[4 * b4 + 0] += sv.x * w; acc[4 * b4 + 1] += sv.y * w; acc[4 * b4 + 2] += sv.z * w; acc[4 * b4 + 3] += sv.w * w; } }
#pragma unroll
            for (int kk = 0; kk < 32; ++kk) { const float w = wv1[kk];
#pragma unroll
                for (int b4 = 0; b4 < 8; ++b4) { const f32x4 sv = *(const LAS f32x4*)(sp + (32 + kk) * 32 + 4 * (b4 ^ (kk & 7)));
                    acc[4 * b4 + 0] += sv.x * w; acc[4 * b4 + 1] += sv.y * w; acc[4 * b4 + 2] += sv.z * w; acc[4 * b4 + 3] += sv.w * w; } }
#pragma unroll
            for (int b = 0; b < 32; ++b) acc[b] += __builtin_bit_cast(float, __builtin_amdgcn_ds_bpermute((lane ^ 32) << 2, __builtin_bit_cast(int, acc[b])));
#pragma unroll 1
            for (int w = 0; w < 8; ++w) {
                if (wave == w && lane < 32) {
#pragma unroll
                    for (int b = 0; b < 32; ++b) { if (w == 0) red[b * 32 + nl] = acc[b]; else red[b * 32 + nl] += acc[b]; } }
                __syncthreads();
            }
            { const float bb = b_ada[cb * 32 + (tid & 31)];
#pragma unroll
              for (int j = 0; j < 2; ++j) { const int b = (tid >> 5) + 16 * j; MOD[b * 6144 + cb * 32 + (tid & 31)] = red[b * 32 + (tid & 31)] + bb; } }
            __syncthreads();
        }
        {
            LAS float* scr = (LAS float*)(ldsb + wave * 16384);
            constexpr int I_IN = (D / 64) * (INW / 32), I_OUT = (D / 64) * (D / 32), I_ALL0 = I_IN + I_OUT + 128, I_HEAD = I_ALL0 - NGV * NWAVES;
            const bool split = (G == 256);
            int it, ie, st;
            if (split) { if (bx >= NGV) { it = (bx - NGV) * NWAVES + wave; ie = I_HEAD; st = (256 - NGV) * NWAVES; } else { it = I_HEAD + bx * NWAVES + wave; ie = I_ALL0; st = I_ALL0; } }
            else { it = gw; ie = I_ALL0; st = NGW; }
            for (; it < ie; it += st) {
                if (it < I_IN) transpose_item<1>(w_in, D, INW, WBIN, scr, it, lane);
                else if (it < I_IN + I_OUT) transpose_item<0>(w_out, D, D, WBOUT, scr, it - I_IN, lane);
                else { const int q = it - I_IN - I_OUT;
                    const int gsel = q >> 6, nb8 = (q >> 3) & 7, sub = q & 7;
                    transpose_item<0>((gsel ? w_ig : w_rg) + (size_t)nb8 * 16384, 128, 128, (gsel ? WIGT : WRGT) + (size_t)nb8 * 16384, scr, sub, lane); }
            }
        }
        {
            const bool split = (G == 256);
            if (!split || bx >= NGV) {
                const int gt = split ? ((bx - NGV) * NWAVES + wave) * 64 + lane : gw * 64 + lane, NT = split ? (256 - NGV) * NWAVES * 64 : NGW * 64;
                for (int i = gt; i < INW; i += NT) BINP[rowmap_in(i)] = b_in[i];
                for (int i = gt; i < NE * 2048; i += NT) { const int e = i >> 11, c = i & 2047; BE1P[e * 2048 + rowmap_e1(c)] = b_e1[i]; }
                for (int i = gt; i < D; i += NT) { const float a = lru_a[i]; const float sp = a > 20.f ? a : log1pf(expf(a)); LC[i] = -8.0f * sp; }
            }
        }
    }
    }
    SEAM(0);

    REP(1) { REPBAR();
    if (IN(1)) {
        for (int ci = gw; ci < T / 32; ci += NGW) {
            const int r0 = ci * 32, b = r0 >> 11; const float* md = MOD + b * 6144;
            f32x4 ga[4], gb[4];
#pragma unroll
            for (int j = 0; j < 4; ++j) { const int d = 4 * lane + 256 * j; const f32x4 g = *(const f32x4*)(g_pre_mix + d), sc = *(const f32x4*)(md + 1024 + d); ga[j] = g * (1.0f + sc); gb[j] = *(const f32x4*)(md + d); }
            for (int r = 0; r < 32; ++r) { const size_t row = (size_t)(r0 + r);
                f32x4 v[4]; float ss = 0.f;
#pragma unroll
                for (int j = 0; j < 4; ++j) { v[j] = *(const f32x4*)(x_in + row * D + 4 * lane + 256 * j); ss += (v[j].x * v[j].x + v[j].y * v[j].y) + (v[j].z * v[j].z + v[j].w * v[j].w); }
                const float rs = rsqrtf(wave_sum(ss) * (1.0f / D) + EPS);
#pragma unroll
                for (int j = 0; j < 4; ++j) { const f32x4 o = v[j] * rs * ga[j] + gb[j]; v2u w; w.x = pk2(o.x, o.y); w.y = pk2(o.z, o.w); *(v2u*)(HB + row * D + 4 * lane + 256 * j) = w; }
            }
        }
    }
    }
    SEAM(1);

    REP(2) { REPBAR();
    if (IN(2)) {
        pg8::Gemm g{HB, WBIN, D, nullptr, 0}; pg8::StaticOrder S; S.init(T / 256, INW / 256, G, bx);
        pg8::EpiIn E{PROJ, BINP, positions};
        LAS int* utab = (LAS int*)(ldsb + UTAB_OFF);
        { pg8::Unit ut; int t9 = threadIdx.x; asm volatile("" : "+v"(t9)); __syncthreads();
          if (t9 < UTAB_UNITS) utab[t9] = S.next(t9, ut) ? (ut.pm | (ut.pn << 16)) : -1;
          __syncthreads(); }
        pg8::TableOrder TS{utab};
        pg8::gemm_phase<pg8::EpiIn, pg8::TableOrder, true, true, false, false, GEMM_PF>(ldsb, g, TS, E);
    }
    }
    SEAM(2);

    REP(3) { REPBAR();
    if (IN(3)) {
        constexpr int A_KS = 144, A_VS = 520, A_VOFF = 256 * A_KS;
        const int hh = lane >> 5, ql = lane & 31;
        v4u kkn[4], vvn[4];
#define ATT_LOAD_KV(un_) do { const int kvh_ = (un_) & 3, nb_ = ((un_) >> 2) & 15, b_ = (un_) >> 6; const int t0_ = b_ * SEQ + nb_ * 128; \
            _Pragma("unroll") for (int i = 0; i < 4; ++i) { const int ck = tid + 512 * i, key = ck >> 3, dc = ck & 7; kkn[i] = (v4u){0u, 0u, 0u, 0u}; vvn[i] = (v4u){0u, 0u, 0u, 0u}; \
                if (nb_ > 0 || key >= 128) { const size_t ro = (size_t)(t0_ - 128 + key) * INW + 64 * kvh_ + 8 * dc; kkn[i] = *(const v4u*)(PROJ + ro + C_K); vvn[i] = *(const v4u*)(PROJ + ro + C_V); } } } while (0)
        if (bx < BATCH * 16 * 4) ATT_LOAD_KV(bx);
        for (int un = bx; un < BATCH * 16 * 4; un += G) {
            const int kvh = un & 3, nb = (un >> 2) & 15, b = un >> 6;
            const int t0 = b * SEQ + nb * 128;
            const int hq = kvh * 4 + (wave >> 1);
            bf16x8 qf[2][4];
#pragma unroll
            for (int qt = 0; qt < 2; ++qt)
#pragma unroll
                for (int sx = 0; sx < 4; ++sx) qf[qt][sx] = *(const bf16x8*)(PROJ + (size_t)(t0 + (wave & 1) * 64 + 32 * qt + ql) * INW + 64 * hq + 16 * sx + 8 * hh);
            LDS_BARRIER();
#pragma unroll
            for (int i = 0; i < 4; ++i) {
                const int ck = tid + 512 * i, key = ck >> 3, dc = ck & 7;
                const v4u kk = kkn[i], vv = vvn[i];
                *(LAS v4u*)(ldsb + key * A_KS + dc * 16) = kk;
                LAS unsigned short* vt = (LAS unsigned short*)(ldsb + A_VOFF + (8 * dc) * A_VS + key * 2);
                vt[0 * (A_VS / 2)] = (unsigned short)(vv.x & 0xffffu); vt[1 * (A_VS / 2)] = (unsigned short)(vv.x >> 16);
                vt[2 * (A_VS / 2)] = (unsigned short)(vv.y & 0xffffu); vt[3 * (A_VS / 2)] = (unsigned short)(vv.y >> 16);
                vt[4 * (A_VS / 2)] = (unsigned short)(vv.z & 0xffffu); vt[5 * (A_VS / 2)] = (unsigned short)(vv.z >> 16);
                vt[6 * (A_VS / 2)] = (unsigned short)(vv.w & 0xffffu); vt[7 * (A_VS / 2)] = (unsigned short)(vv.w >> 16);
            }
            LDS_BARRIER();
            if (un + G < BATCH * 16 * 4) ATT_LOAD_KV(un + G);
            const float sink2 = sinks[hq] * LOG2E;
#pragma unroll
            for (int qt = 0; qt < 2; ++qt) {
                const int i0 = (wave & 1) * 64 + 32 * qt, kt0 = i0 >> 5;
                const size_t qrow = (size_t)(t0 + i0 + ql);
                f32x16 S[5];
#pragma unroll
                for (int kk = 0; kk < 5; ++kk) {
#pragma unroll
                    for (int r = 0; r < 16; ++r) S[kk][r] = 0.f;
#pragma unroll
                    for (int sx = 0; sx < 4; ++sx) { const bf16x8 kf = *(const LAS bf16x8*)(ldsb + (32 * (kt0 + kk) + ql) * A_KS + 32 * sx + 16 * hh);
                        S[kk] = __builtin_amdgcn_mfma_f32_32x32x16_bf16(kf, qf[qt][sx], S[kk], 0, 0, 0); }
                }
#pragma unroll
                for (int r = 0; r < 16; ++r) { const int cr = (r & 3) + 8 * (r >> 2) + 4 * hh; if (!(cr > ql)) S[0][r] = -INFINITY; if (!(cr <= ql)) S[4][r] = -INFINITY; }
                if (nb == 0) {
#pragma unroll
                    for (int kk = 0; kk < 4; ++kk) if (kt0 + kk < 4) {
#pragma unroll
                        for (int r = 0; r < 16; ++r) S[kk][r] = -INFINITY; }
                }
                float m = sink2;
#pragma unroll
                for (int kk = 0; kk < 5; ++kk)
#pragma unroll
                    for (int r = 0; r < 16; ++r) m = fmaxf(m, S[kk][r]);
                m = fmaxf(m, __shfl_xor(m, 32));
                float l = 0.f;
#pragma unroll
                for (int kk = 0; kk < 5; ++kk)
#pragma unroll
                    for (int r = 0; r < 16; ++r) { const float p = __builtin_amdgcn_exp2f(S[kk][r] - m); S[kk][r] = p; l += p; }
                l += __shfl_xor(l, 32);
                l += __builtin_amdgcn_exp2f(sink2 - m);
                f32x16 O0, O1;
#pragma unroll
                for (int r = 0; r < 16; ++r) { O0[r] = 0.f; O1[r] = 0.f; }
#pragma unroll
                for (int kk = 0; kk < 5; ++kk)
#pragma unroll
                    for (int s2 = 0; s2 < 2; ++s2) {
                        u32x4v pw; pw.x = pkbf(S[kk][8 * s2 + 0], S[kk][8 * s2 + 1]); pw.y = pkbf(S[kk][8 * s2 + 2], S[kk][8 * s2 + 3]); pw.z = pkbf(S[kk][8 * s2 + 4], S[kk][8 * s2 + 5]); pw.w = pkbf(S[kk][8 * s2 + 6], S[kk][8 * s2 + 7]);
                        const bf16x8 pf = __builtin_bit_cast(bf16x8, pw);
                        const int kb = (32 * (kt0 + kk) + 16 * s2 + 4 * hh) * 2;
                        { const v2u a0 = *(const LAS v2u*)(ldsb + A_VOFF + ql * A_VS + kb), a1 = *(const LAS v2u*)(ldsb + A_VOFF + ql * A_VS + kb + 16);
                          u32x4v vw; vw.x = a0.x; vw.y = a0.y; vw.z = a1.x; vw.w = a1.y; O0 = __builtin_amdgcn_mfma_f32_32x32x16_bf16(__builtin_bit_cast(bf16x8, vw), pf, O0, 0, 0, 0); }
                        { const v2u a0 = *(const LAS v2u*)(ldsb + A_VOFF + (32 + ql) * A_VS + kb), a1 = *(const LAS v2u*)(ldsb + A_VOFF + (32 + ql) * A_VS + kb + 16);
                          u32x4v vw; vw.x = a0.x; vw.y = a0.y; vw.z = a1.x; vw.w = a1.y; O1 = __builtin_amdgcn_mfma_f32_32x32x16_bf16(__builtin_bit_cast(bf16x8, vw), pf, O1, 0, 0, 0); }
                    }
                const float il = __builtin_amdgcn_rcpf(l);
                bf16* orow = HB + qrow * D + 64 * hq + 4 * hh;
#pragma unroll
                for (int g4 = 0; g4 < 4; ++g4) {
                    v2u w0; w0.x = pkbf(O0[4 * g4 + 0] * il, O0[4 * g4 + 1] * il); w0.y = pkbf(O0[4 * g4 + 2] * il, O0[4 * g4 + 3] * il); *(v2u*)(orow + 8 * g4) = w0;
                    v2u w1; w1.x = pkbf(O1[4 * g4 + 0] * il, O1[4 * g4 + 1] * il); w1.y = pkbf(O1[4 * g4 + 2] * il, O1[4 * g4 + 3] * il); *(v2u*)(orow + 32 + 8 * g4) = w1;
                }
            }
        }
        __syncthreads();
    }
    }
    SEAM(3);
    {
        constexpr int pass = 1;
        _Pragma("unroll") for (int rep_ = 0; rep_ < 1 + ((DBL_MASK >> 4) & 1); ++rep_) { REPBAR();
        if (IN(4)) {
            constexpr int L_RS = 272, L_HOFF = 128 * L_RS, L_RAW = 2 * 128 * L_RS, L_CW = L_RAW + 132 * 256;
            const int q4 = lane >> 4, el = 16 * wave + (lane & 15);
            int n_prev = -1;
            bf16x8 br[4], bi[4]; float brg = 0.f, big = 0.f, lc = 0.f;
            LAS float* cwt = (LAS float*)(ldsb + L_CW);
            for (int un2 = bx; un2 < BATCH * 8; un2 += G) {
              const int n = un2 & 7, b = un2 >> 3;
              float carry = 0.f;
#pragma unroll 1
              for (int c = 0; c < 16; ++c) {
                const int t0 = b * SEQ + c * 128;
                const int chg = n * 128 + el;
                if (n != n_prev) {
                    n_prev = n;
                    __syncthreads();
                    for (int i = tid; i < 5 * 128; i += 512) { const int tp = i >> 7, ch = i & 127; cwt[i] = tp < 4 ? conv_w[tp * 1024 + n * 128 + ch] : conv_b[n * 128 + ch]; }
#pragma unroll
                    for (int ks = 0; ks < 4; ++ks) { br[ks] = *(const bf16x8*)(WRGT + (size_t)n * 16384 + el * 128 + 32 * ks + 8 * q4); bi[ks] = *(const bf16x8*)(WIGT + (size_t)n * 16384 + el * 128 + 32 * ks + 8 * q4); }
                    brg = b_rg[chg]; big = b_ig[chg]; lc = LC[chg];
                    __builtin_amdgcn_s_waitcnt(0x0F70);
                }
#define LRU_ISSUE_RAW(c_) do { const unsigned rawl_ = (unsigned)__builtin_amdgcn_readfirstlane((int)(unsigned)(size_t)(ldsb + L_RAW)); \
                    for (int g_ = wave; g_ < 33; g_ += NWAVES) { const char* gb_ = (const char*)PROJ + ((size_t)((long)(b * SEQ + (c_) * 128 - 3 + 4 * g_)) * INW + C_LX + n * 128) * 2; \
                        pg8::glds16(gb_, (unsigned)((lane >> 4) * (INW * 2) + (lane & 15) * 16), rawl_ + (unsigned)(g_ * 1024)); } } while (0)
                if (c == 0) { LRU_ISSUE_RAW(0); asm volatile("s_waitcnt vmcnt(0)" ::: "memory"); }
                LDS_BARRIER();
                { const int cc = tid & 15;
                  float cw[4][8], cbv[8];
#pragma unroll
                  for (int tp = 0; tp < 5; ++tp) { const f32x4 w0 = *(const LAS f32x4*)(cwt + tp * 128 + 8 * cc), w1 = *(const LAS f32x4*)(cwt + tp * 128 + 8 * cc + 4);
                      if (tp < 4) { cw[tp][0] = w0.x; cw[tp][1] = w0.y; cw[tp][2] = w0.z; cw[tp][3] = w0.w; cw[tp][4] = w1.x; cw[tp][5] = w1.y; cw[tp][6] = w1.z; cw[tp][7] = w1.w; }
                      else { cbv[0] = w0.x; cbv[1] = w0.y; cbv[2] = w0.z; cbv[3] = w0.w; cbv[4] = w1.x; cbv[5] = w1.y; cbv[6] = w1.z; cbv[7] = w1.w; } }
#pragma unroll
                  for (int i = 0; i < 4; ++i) {
                      const int tok = (tid >> 4) + 32 * i, sl = c * 128 + tok;
                      float o[8];
#pragma unroll
                      for (int e = 0; e < 8; ++e) o[e] = cbv[e];
#pragma unroll
                      for (int tp = 0; tp < 4; ++tp) {
                          v4u w = *(const LAS v4u*)(ldsb + L_RAW + (tok + tp) * 256 + cc * 16);
                          if (sl - 3 + tp < 0) w = (v4u){0u, 0u, 0u, 0u};
                          o[0] += bflo(w.x) * cw[tp][0]; o[1] += bfhi(w.x) * cw[tp][1]; o[2] += bflo(w.y) * cw[tp][2]; o[3] += bfhi(w.y) * cw[tp][3];
                          o[4] += bflo(w.z) * cw[tp][4]; o[5] += bfhi(w.z) * cw[tp][5]; o[6] += bflo(w.w) * cw[tp][6]; o[7] += bfhi(w.w) * cw[tp][7];
                      }
                      v4u pw; pw.x = pkbf(o[0], o[1]); pw.y = pkbf(o[2], o[3]); pw.z = pkbf(o[4], o[5]); pw.w = pkbf(o[6], o[7]);
                      *(LAS v4u*)(ldsb + tok * L_RS + cc * 16) = pw;
                  } }
                LDS_BARRIER();
                if (c + 1 < 16) LRU_ISSUE_RAW(c + 1);
                v4u mly[4], mga[4], mat[4];
                { const int cc0 = tid & 15, chg00 = n * 128 + 8 * cc0;
#pragma unroll
                  for (int i = 0; i < 4; ++i) { const size_t tg = (size_t)(t0 + (tid >> 4) + 32 * i); const bf16* pr = PROJ + tg * INW + chg00;
                      mly[i] = *(const v4u*)(pr + C_LY); mga[i] = *(const v4u*)(pr + C_GA); mat[i] = *(const v4u*)(HB + tg * D + chg00); }
                  asm volatile("" ::: "memory"); }
                if (LRU_STOP == 1 && rep_ == 0 && ((DBL_MASK >> 4) & 1)) continue;
                f32x4 R[8], I[8];
                { bf16x8 afc[4], afn[4];
#pragma unroll
                  for (int ks = 0; ks < 4; ++ks) afc[ks] = *(const LAS bf16x8*)(ldsb + (lane & 15) * L_RS + 64 * ks + 16 * q4);
#pragma unroll
                  for (int m = 0; m < 8; ++m) { R[m] = (f32x4){0.f, 0.f, 0.f, 0.f}; I[m] = (f32x4){0.f, 0.f, 0.f, 0.f};
                      if (m < 7) {
#pragma unroll
                          for (int ks = 0; ks < 4; ++ks) afn[ks] = *(const LAS bf16x8*)(ldsb + (16 * (m + 1) + (lane & 15)) * L_RS + 64 * ks + 16 * q4); }
#pragma unroll
                      for (int ks = 0; ks < 4; ++ks) { R[m] = __builtin_amdgcn_mfma_f32_16x16x32_bf16(afc[ks], br[ks], R[m], 0, 0, 0); I[m] = __builtin_amdgcn_mfma_f32_16x16x32_bf16(afc[ks], bi[ks], I[m], 0, 0, 0); }
#pragma unroll
                      for (int ks = 0; ks < 4; ++ks) afc[ks] = afn[ks]; } }
#pragma unroll
                for (int m = 0; m < 8; ++m)
#pragma unroll
                    for (int r = 0; r < 4; ++r) {
                        const int tok = 16 * m + 4 * q4 + r;
                        const float xv = bf1(*(const LAS unsigned short*)(ldsb + tok * L_RS + el * 2));
                        const float rs = pg8::sigm(R[m][r] + brg), is = pg8::sigm(I[m][r] + big);
                        const float la = lc * rs, av = __builtin_amdgcn_exp2f(1.4426950408889634f * la), mult = __builtin_amdgcn_sqrtf(fmaxf(1.0f - av * av, 0.0f));
                        R[m][r] = av; I[m][r] = mult * (is * xv);
                    }
                if (LRU_STOP == 2 && rep_ == 0 && ((DBL_MASK >> 4) & 1)) { asm volatile("" :: "v"(R[0]), "v"(I[0]), "v"(R[7]), "v"(I[7])); continue; }
                float sA[8], sH[8], Ae[8], He[8], At[8], Ht[8];
#pragma unroll
                for (int m = 0; m < 8; ++m) { float A = R[m][0], H = I[m][0];
#pragma unroll
                    for (int r = 1; r < 4; ++r) { H = R[m][r] * H + I[m][r]; A *= R[m][r]; }
                    sA[m] = A; sH[m] = H; }
#pragma unroll
                for (int m = 0; m < 8; ++m) { const float Ap = __shfl_up(sA[m], 16), Hp = __shfl_up(sH[m], 16); if (q4 >= 1) { sH[m] = sA[m] * Hp + sH[m]; sA[m] = sA[m] * Ap; } }
#pragma unroll
                for (int m = 0; m < 8; ++m) { const float Ap = __shfl_up(sA[m], 32), Hp = __shfl_up(sH[m], 32); if (q4 >= 2) { sH[m] = sA[m] * Hp + sH[m]; sA[m] = sA[m] * Ap; } }
#pragma unroll
                for (int m = 0; m < 8; ++m) { Ae[m] = __shfl_up(sA[m], 16); He[m] = __shfl_up(sH[m], 16); if (q4 == 0) { Ae[m] = 1.0f; He[m] = 0.0f; }
                    At[m] = __shfl(sA[m], 48 + (lane & 15)); Ht[m] = __shfl(sH[m], 48 + (lane & 15)); }
#pragma unroll
                for (int m = 0; m < 8; ++m) {
                    if (pass == 1) {
                        float hp = Ae[m] * carry + He[m];
#pragma unroll
                        for (int r = 0; r < 4; ++r) { hp = R[m][r] * hp + I[m][r]; *(LAS unsigned short*)(ldsb + L_HOFF + (16 * m + 4 * q4 + r) * L_RS + el * 2) = (unsigned short)(pkbf(hp, 0.f) & 0xffffu); }
                    }
                    carry = At[m] * carry + Ht[m];
                }
                if (LRU_STOP == 3 && rep_ == 0 && ((DBL_MASK >> 4) & 1)) continue;
                {
                    const int cc = tid & 15, chg0 = n * 128 + 8 * cc;
                    LDS_BARRIER();
#pragma unroll
                    for (int i = 0; i < 4; ++i) {
                        const int tok = (tid >> 4) + 32 * i; const size_t tg = (size_t)(t0 + tok);
                        const v4u hv = *(const LAS v4u*)(ldsb + L_HOFF + tok * L_RS + cc * 16);
                        const v4u ly = mly[i], ga = mga[i], at = mat[i];
                        v4u ow;
                        ow.x = pkbf(bflo(ga.x) * bflo(at.x) + bflo(hv.x) * bflo(ly.x), bfhi(ga.x) * bfhi(at.x) + bfhi(hv.x) * bfhi(ly.x));
                        ow.y = pkbf(bflo(ga.y) * bflo(at.y) + bflo(hv.y) * bflo(ly.y), bfhi(ga.y) * bfhi(at.y) + bfhi(hv.y) * bfhi(ly.y));
                        ow.z = pkbf(bflo(ga.z) * bflo(at.z) + bflo(hv.z) * bflo(ly.z), bfhi(ga.z) * bfhi(at.z) + bfhi(hv.z) * bfhi(ly.z));
                        ow.w = pkbf(bflo(ga.w) * bflo(at.w) + bflo(hv.w) * bflo(ly.w), bfhi(ga.w) * bfhi(at.w) + bfhi(hv.w) * bfhi(ly.w));
                        *(v4u*)(MRG + tg * D + chg0) = ow;
                    }
                }
              }
            }
            LDS_BARRIER();
        }
        }
        SEAM(4);
    }

    REP(5) { REPBAR();
    if (IN(5)) {
        pg8::Gemm g{MRG, WBOUT, D, nullptr, 0}; pg8::StaticOrder S; S.init(T / 256, D / 256, G, bx);
        pg8::EpiBf16 E{Y1, D, b_out};
        LAS int* utab = (LAS int*)(ldsb + UTAB_OFF);
        { pg8::Unit ut; int t9 = threadIdx.x; asm volatile("" : "+v"(t9)); __syncthreads();
          if (t9 < UTAB_UNITS) utab[t9] = S.next(t9, ut) ? (ut.pm | (ut.pn << 16)) : -1;
          __syncthreads(); }
        pg8::TableOrder TS{utab};
        pg8::gemm_phase<pg8::EpiBf16, pg8::TableOrder, true, true, false, false, GEMM_PF>(ldsb, g, TS, E);
    }
    }
    SEAM(5);

    REP(6) { REPBAR();
    if (IN(6)) {
        _Pragma("unroll") for (int rp_ = 0; rp_ < 1 + ((DBL_MASK >> 10) & 1); ++rp_)
        {
            LAS float* scr = (LAS float*)(ldsb + wave * 16384);
            constexpr int I_E1 = (D / 64) * (2048 / 32), I_E2 = (D / 64) * (D / 32), I_ALL = NE * (I_E1 + I_E2);
#define CV_DECODE(it_, W_, WT_, N_, k0_, n0_, m2_) do { const int i_ = (it_); if (i_ < NE * I_E1) { const int e_ = i_ / I_E1, r_ = i_ - e_ * I_E1; W_ = w_e1 + (size_t)e_ * D * 2048; WT_ = WBE1 + (size_t)e_ * 2048 * D; N_ = 2048; m2_ = true; k0_ = 64 * (r_ / 64); n0_ = 32 * (r_ % 64); } \
                else { const int q_ = i_ - NE * I_E1, e_ = q_ / I_E2, r_ = q_ - e_ * I_E2; W_ = w_e2 + (size_t)e_ * D * D; WT_ = WBE2 + (size_t)e_ * D * D; N_ = D; m2_ = false; k0_ = 64 * (r_ / 32); n0_ = 32 * (r_ % 32); } } while (0)
#define CV_LOAD(it_, tv_) do { const float* W_; unsigned char* WT_; int N_, k0_, n0_; bool m2_; CV_DECODE(it_, W_, WT_, N_, k0_, n0_, m2_); (void)WT_; (void)m2_; \
                _Pragma("unroll") for (int i = 0; i < 32; ++i) tv_[i] = W_[(size_t)(k0_ + 2 * i + (lane >> 5)) * N_ + n0_ + (lane & 31)]; } while (0)
#define CV_FINISH(it_, tv_) do { const float* W_; unsigned char* WT_; int N_, k0_, n0_; bool m2_; CV_DECODE(it_, W_, WT_, N_, k0_, n0_, m2_); (void)W_; \
                _Pragma("unroll") for (int i = 0; i < 32; ++i) scr[(2 * i + (lane >> 5)) * 33 + (lane & 31)] = tv_[i]; \
                LDS_WAIT(); asm volatile("" ::: "memory"); \
                const int c_ = lane & 7; \
                _Pragma("unroll") for (int j = 0; j < 4; ++j) { const int n_ = (lane >> 3) + 8 * j; const LAS float* sp = scr + (8 * c_) * 33 + n_; \
                    v2u o; o.x = pg8::pk4_fp8(sp[0 * 33] * pg8::W8_SCALE, sp[1 * 33] * pg8::W8_SCALE, sp[2 * 33] * pg8::W8_SCALE, sp[3 * 33] * pg8::W8_SCALE); \
                    o.y = pg8::pk4_fp8(sp[4 * 33] * pg8::W8_SCALE, sp[5 * 33] * pg8::W8_SCALE, sp[6 * 33] * pg8::W8_SCALE, sp[7 * 33] * pg8::W8_SCALE); \
                    const int nn_ = n0_ + n_; const int row_ = m2_ ? rowmap_e1(nn_) : nn_; \
                    *(GAS v2u*)(WT_ + (size_t)row_ * D + k0_ + 8 * c_) = o; } \
                LDS_WAIT(); asm volatile("" ::: "memory"); } while (0)
            float ta[32], tb[32];
            int it = gw;
            if (it < I_ALL) {
                CV_LOAD(it, ta);
                for (;;) {
                    const int it2 = it + NGW; { const int c2 = it2 < I_ALL ? it2 : I_ALL - 1; CV_LOAD(c2, tb); }
                    CV_FINISH(it, ta);
                    if (it2 >= I_ALL) break;
                    const int it3 = it2 + NGW; { const int c3 = it3 < I_ALL ? it3 : I_ALL - 1; CV_LOAD(c3, ta); }
                    CV_FINISH(it2, tb);
                    if (it3 >= I_ALL) break;
                    it = it3;
                }
            }
#undef CV_DECODE
#undef CV_LOAD
#undef CV_FINISH
        }
        __syncthreads();
        constexpr int HT_RS = 1028;
        LAS float* Ht = (LAS float*)ldsb;
        LAS float* part = (LAS float*)(ldsb + 16 * HT_RS * 4);
        float wB[8][4][2];
#pragma unroll
        for (int sx = 0; sx < 8; ++sx)
#pragma unroll
            for (int i4 = 0; i4 < 4; ++i4)
#pragma unroll
                for (int nt = 0; nt < 2; ++nt) wB[sx][i4][nt] = w_router[(size_t)(128 * wave + 16 * sx + 4 * (lane >> 4) + i4) * NE + (lane & 15) + 16 * nt];
        volatile LAS unsigned* lcnt = MISC + 32;
        _Pragma("unroll") for (int rp_ = 0; rp_ < 1 + ((DBL_MASK >> 11) & 1) + ((DBL_MASK >> 12) & 1); ++rp_)
        for (int grp = bx; grp < NGRP; grp += G) {
            const bool lite_ = ((DBL_MASK >> 12) & 1) && rp_ == 0;
            __syncthreads();
            if (tid < 32) lcnt[tid] = 0u;
            __syncthreads();
            const int b = (grp * 256) >> 11; const float* md = MOD + b * 6144;
            LAS float* pcn = (LAS float*)(ldsb + LDSCTL_OFF + 1024);
            if (wave == 0) {
#pragma unroll
                for (int j = 0; j < 4; ++j) { const int d = 4 * lane + 256 * j;
                    *(LAS f32x4*)(pcn + d) = *(const f32x4*)(md + 2048 + d) * *(const f32x4*)(g_post_mix + d);
                    *(LAS f32x4*)(pcn + 1024 + d) = *(const f32x4*)(g_pre_ffn + d) * (1.0f + *(const f32x4*)(md + 4096 + d));
                    *(LAS f32x4*)(pcn + 2048 + d) = *(const f32x4*)(md + 3072 + d); } }
            __syncthreads();
#define A1(j) (*(const LAS f32x4*)(pcn + 4 * lane + 256 * (j)))
#define A2(j) (*(const LAS f32x4*)(pcn + 1024 + 4 * lane + 256 * (j)))
#define B2(j) (*(const LAS f32x4*)(pcn + 2048 + 4 * lane + 256 * (j)))
            const float brt = b_router[lane & 31];
            v2u yn[2][4]; f32x4 xn[2][4];
#pragma unroll
            for (int u = 0; u < 2; ++u) { const size_t ro = (size_t)(grp * 256 + wave + 8 * u) * D;
#pragma unroll
              for (int j = 0; j < 4; ++j) { yn[u][j] = *(const v2u*)(Y1 + ro + 4 * lane + 256 * j); xn[u][j] = *(const f32x4*)(x_in + ro + 4 * lane + 256 * j); } }
#pragma unroll 1
            for (int rr = wave; rr < 256; rr += 16) {
                int lane_o = threadIdx.x & 63; asm volatile("" : "+v"(lane_o)); const int lane = lane_o;
                f32x4 v[2][4];
#pragma unroll
                for (int u = 0; u < 2; ++u)
#pragma unroll
                    for (int j = 0; j < 4; ++j) v[u][j] = (f32x4){bflo(yn[u][j].x), bfhi(yn[u][j].x), bflo(yn[u][j].y), bfhi(yn[u][j].y)};
                float ss[2], r1[2], ss2[2], r2[2];
#pragma unroll
                for (int u = 0; u < 2; ++u) { ss[u] = 0.f;
#pragma unroll
                    for (int j = 0; j < 4; ++j) ss[u] += (v[u][j].x * v[u][j].x + v[u][j].y * v[u][j].y) + (v[u][j].z * v[u][j].z + v[u][j].w * v[u][j].w); }
#pragma unroll
                for (int u = 0; u < 2; ++u) r1[u] = rsqrtf(wave_sum(ss[u]) * (1.0f / D) + EPS);
#pragma unroll
                for (int u = 0; u < 2; ++u) { const size_t ro = (size_t)(grp * 256 + rr + 8 * u) * D; ss2[u] = 0.f;
#pragma unroll
                    for (int j = 0; j < 4; ++j) { v[u][j] = xn[u][j] + v[u][j] * r1[u] * A1(j);
                        *(f32x4*)(out + ro + 4 * lane + 256 * j) = v[u][j]; ss2[u] += (v[u][j].x * v[u][j].x + v[u][j].y * v[u][j].y) + (v[u][j].z * v[u][j].z + v[u][j].w * v[u][j].w); } }
                if (rr + 16 < 256) {
#pragma unroll
                    for (int u = 0; u < 2; ++u) { const size_t rn = (size_t)(grp * 256 + rr + 16 + 8 * u) * D;
#pragma unroll
                        for (int j = 0; j < 4; ++j) { yn[u][j] = *(const v2u*)(Y1 + rn + 4 * lane + 256 * j); xn[u][j] = *(const f32x4*)(x_in + rn + 4 * lane + 256 * j); } } }
#pragma unroll
                for (int u = 0; u < 2; ++u) r2[u] = rsqrtf(wave_sum(ss2[u]) * (1.0f / D) + EPS);
#pragma unroll
                for (int u = 0; u < 2; ++u) { const size_t ro = (size_t)(grp * 256 + rr + 8 * u) * D;
#pragma unroll
                    for (int j = 0; j < 4; ++j) { v[u][j] = v[u][j] * r2[u] * A2(j) + B2(j); *(unsigned*)(H8 + ro + 4 * lane + 256 * j) = pg8::pk4_fp8(v[u][j].x, v[u][j].y, v[u][j].z, v[u][j].w); } }
#pragma unroll
                for (int u = 0; u < 2; ++u)
#pragma unroll
                    for (int j = 0; j < 4; ++j) *(LAS f32x4*)(Ht + (wave + 8 * u) * HT_RS + 4 * lane + 256 * j) = v[u][j];
                LDS_BARRIER();
                if (!lite_) {
                    f32x4 pa0 = {0.f, 0.f, 0.f, 0.f}, pa1 = {0.f, 0.f, 0.f, 0.f};
#pragma unroll
                    for (int sx = 0; sx < 8; ++sx) { const f32x4 av = *(const LAS f32x4*)(Ht + (lane & 15) * HT_RS + 128 * wave + 16 * sx + 4 * (lane >> 4));
#pragma unroll
                        for (int i4 = 0; i4 < 4; ++i4) { pa0 = __builtin_amdgcn_mfma_f32_16x16x4f32(av[i4], wB[sx][i4][0], pa0, 0, 0, 0); pa1 = __builtin_amdgcn_mfma_f32_16x16x4f32(av[i4], wB[sx][i4][1], pa1, 0, 0, 0); } }
#pragma unroll
                    for (int r = 0; r < 4; ++r) { part[(wave * 16 + 4 * (lane >> 4) + r) * 32 + (lane & 15)] = pa0[r]; part[(wave * 16 + 4 * (lane >> 4) + r) * 32 + 16 + (lane & 15)] = pa1[r]; }
                }
                LDS_BARRIER();
                if (lite_) continue;
                float val = brt;
#pragma unroll
                for (int w8 = 0; w8 < 8; ++w8) val += part[(w8 * 16 + wave + 8 * (lane >> 5)) * 32 + (lane & 31)];
                const int myE = lane & 31;
                int rank = 0;
#pragma unroll
                for (int e = 0; e < 32; ++e) { const float v0 = __int_as_float(__builtin_amdgcn_readlane(__float_as_int(val), e)), v1 = __int_as_float(__builtin_amdgcn_readlane(__float_as_int(val), 32 + e));
                    const float ve = lane < 32 ? v0 : v1; rank += (ve > val || (ve == val && e < myE)) ? 1 : 0; }
                float tv[2][4]; int ti[2][4];
#pragma unroll
                for (int k = 0; k < 4; ++k) { const unsigned long long mk = __ballot(rank == k);
                    const int s0 = (int)__builtin_ctz((unsigned)mk), s1 = 32 + (int)__builtin_ctz((unsigned)(mk >> 32));
                    ti[0][k] = s0; ti[1][k] = s1 - 32; tv[0][k] = __int_as_float(__builtin_amdgcn_readlane(__float_as_int(val), s0)); tv[1][k] = __int_as_float(__builtin_amdgcn_readlane(__float_as_int(val), s1)); }
                if (lane == 0 || lane == 32) {
                    const int u = lane >> 5; const int t = grp * 256 + rr + 8 * u;
                    const float t0v = u ? tv[1][0] : tv[0][0], t1v = u ? tv[1][1] : tv[0][1], t2v = u ? tv[1][2] : tv[0][2], t3v = u ? tv[1][3] : tv[0][3];
                    const int i0 = u ? ti[1][0] : ti[0][0], i1 = u ? ti[1][1] : ti[0][1], i2 = u ? ti[1][2] : ti[0][2], i3 = u ? ti[1][3] : ti[0][3];
                    const float e1 = __expf(t1v - t0v), e2 = __expf(t2v - t0v), e3 = __expf(t3v - t0v); const float inv = 1.0f / (1.0f + e1 + e2 + e3);
                    const float wv[4] = {inv, e1 * inv, e2 * inv, e3 * inv}; const int iv[4] = {i0, i1, i2, i3};
#pragma unroll
                    for (int k = 0; k < 4; ++k) { const unsigned pos = __hip_atomic_fetch_add((LAS unsigned*)(ldsb + LDSCTL_OFF + 128) + iv[k], 1u, __ATOMIC_RELAXED, __HIP_MEMORY_SCOPE_WORKGROUP);
                        TKI[t * 4 + k] = iv[k]; TKW[t * 4 + k] = wv[k]; TKP[t * 4 + k] = (int)pos; }
                }
            }
#undef A1
#undef A2
#undef B2
            __syncthreads();
            if (tid < 32) CNT[grp * 32 + tid] = (int)lcnt[tid];
        }
    }
    }
    SEAM(6);

    {
        int tidl = threadIdx.x; asm volatile("" : "+v"(tidl));
        REP(7) { REPBAR();
        if (IN(7)) {
            const int tid = tidl;
            LAS int* gbl = (LAS int*)ldsb;
            LAS int* pst = gbl + NGRP * 32;
            LAS int* tot = pst + 32;
            LAS int* nbl = tot + 32;
            __syncthreads();
            if (tid < 32) { int run = 0; for (int g2 = 0; g2 < NGRP; ++g2) { gbl[g2 * 32 + tid] = run; run += ld_agent(CNT + g2 * 32 + tid); } tot[tid] = run; }
            __syncthreads();
            if (tid == 0) { int p = 0; for (int e = 0; e < 32; ++e) { pst[e] = p; p += ((tot[e] + 255) >> 8) << 8; } nbl[0] = p >> 8; }
            __syncthreads();
            const int nblk = nbl[0];
            if (bx == 0) {
                for (int pm = tid; pm < nblk; pm += 512) { int e = 0; for (int q = 0; q < 32; ++q) { const int pend = pst[q] + (((tot[q] + 255) >> 8) << 8); if (pend <= pm * 256) e = q + 1; } BLKE[pm] = e > 31 ? 31 : e; }
                if (tid == 0) NBLK[0] = nblk;
            }
            for (int i = bx * 512 + tid; i < T * 4; i += G * 512) {
                const int t = i >> 2, g2 = t >> 8;
                const int e = TKI[i]; const int slot = pst[e] + gbl[g2 * 32 + e] + TKP[i];
                SLOT[i] = slot; ROWTOK[slot] = (unsigned short)t;
            }
            for (int e = bx; e < 32; e += G) { const int r0 = pst[e] + tot[e], r1 = pst[e] + (((tot[e] + 255) >> 8) << 8);
                for (int r = r0 + tid; r < r1; r += 512) ROWTOK[r] = (unsigned short)0; }
            __syncthreads();
        }
        }
        SEAM(7);
        REP(8) { REPBAR();
        if (IN(8)) {
            const int nblk = ld_agent(NBLK);
            LAS int* etab = (LAS int*)(ldsb + ETAB_OFF);
            pg8::Gemm g{(const bf16*)H8, (const bf16*)WBE1, D, etab, (size_t)2048 * D}; pg8::StaticOrder S; S.init(nblk, 8, G, bx);
            pg8::EpiSwiglu8 E{ACT, BE1P, etab};
            LAS unsigned short* rtab = (LAS unsigned short*)(ldsb + RTAB_OFF);
            { pg8::Unit uu;
              int t8 = threadIdx.x; asm volatile("" : "+v"(t8));
              __syncthreads();
              for (int ui = 0; ui < RTAB_UNITS && S.next(ui, uu); ++ui) if (t8 < 256) rtab[ui * 256 + t8] = ROWTOK[uu.pm * 256 + t8];
              pg8::Unit ue; if (t8 < ETAB_UNITS && S.next(t8, ue)) etab[t8] = ld_agent(BLKE + ue.pm);
              __syncthreads(); }
            LAS int* utab = (LAS int*)(ldsb + UTAB_OFF);
            { pg8::Unit ut; int t9 = threadIdx.x; asm volatile("" : "+v"(t9)); __syncthreads();
              if (t9 < UTAB_UNITS) utab[t9] = S.next(t9, ut) ? (ut.pm | (ut.pn << 16)) : -1;
              __syncthreads(); }
            pg8::TableOrder TS{utab};
            pg8::gemm_phase<pg8::EpiSwiglu8, pg8::TableOrder, true, true, true, true, GEMM_PF>(ldsb, g, TS, E, rtab);
        }
        }
        SEAM(8);
        REP(9) { REPBAR();
        if (IN(9)) {
            const int nblk = ld_agent(NBLK);
            LAS int* etab = (LAS int*)(ldsb + ETAB_OFF);
            pg8::Gemm g{(const bf16*)ACT, (const bf16*)WBE2, D, etab, (size_t)D * D}; pg8::StaticOrder S; S.init(nblk, 4, G, bx);
            pg8::EpiExpOut8 E{YP, b_e2, etab};
            { pg8::Unit uu; int t8 = threadIdx.x; asm volatile("" : "+v"(t8));
              __syncthreads();
              if (t8 < ETAB_UNITS && S.next(t8, uu)) etab[t8] = ld_agent(BLKE + uu.pm);
              __syncthreads(); }
            LAS int* utab = (LAS int*)(ldsb + UTAB_OFF);
            { pg8::Unit ut; int t9 = threadIdx.x; asm volatile("" : "+v"(t9)); __syncthreads();
              if (t9 < UTAB_UNITS) utab[t9] = S.next(t9, ut) ? (ut.pm | (ut.pn << 16)) : -1;
              __syncthreads(); }
            pg8::TableOrder TS{utab};
            pg8::gemm_phase<pg8::EpiExpOut8, pg8::TableOrder, true, true, true, false, GEMM_PF>(ldsb, g, TS, E);
        }
        }
        SEAM(9);
        if (IN(10)) {
            int tid2 = threadIdx.x; asm volatile("" : "+v"(tid2)); const int lane = tid2 & 63;
            for (int ci = gw; ci < T / 32; ci += NGW) {
                const int r0 = ci * 32, b = r0 >> 11; const float* md = MOD + b * 6144;
                f32x4 A3[4];
#pragma unroll
                for (int j = 0; j < 4; ++j) { const int d = 8 * lane + 512 * (j >> 1) + 4 * (j & 1); A3[j] = *(const f32x4*)(md + 5120 + d) * *(const f32x4*)(g_post_ffn + d); }
                const int sl0 = SLOT[r0 * 4 + lane], sl1 = SLOT[r0 * 4 + 64 + lane]; const float wk0 = TKW[r0 * 4 + lane], wk1 = TKW[r0 * 4 + 64 + lane];
                v2u yn[4][2]; f32x4 xn[4];
#pragma unroll
                for (int k = 0; k < 4; ++k) { const int slot = __builtin_amdgcn_readlane(sl0, k); const unsigned char* yp = YP + (size_t)slot * D;
#pragma unroll
                    for (int jh = 0; jh < 2; ++jh) yn[k][jh] = *(const v2u*)(yp + 8 * lane + 512 * jh); }
#pragma unroll
                for (int j = 0; j < 4; ++j) xn[j] = *(const f32x4*)(out + (size_t)r0 * D + 8 * lane + 512 * (j >> 1) + 4 * (j & 1));
#pragma unroll 1
                for (int r = 0; r < 32; ++r) { const int t = r0 + r; const size_t ro = (size_t)t * D;
                    v2u yc[4][2]; f32x4 xc4[4]; float wk[4];
#pragma unroll
                    for (int k = 0; k < 4; ++k) { const int idx = (4 * r + k) & 63; wk[k] = __int_as_float(r < 16 ? __builtin_amdgcn_readlane(__float_as_int(wk0), idx) : __builtin_amdgcn_readlane(__float_as_int(wk1), idx));
                        yc[k][0] = yn[k][0]; yc[k][1] = yn[k][1]; }
#pragma unroll
                    for (int j = 0; j < 4; ++j) xc4[j] = xn[j];
                    if (r + 1 < 32) {
#pragma unroll
                        for (int k = 0; k < 4; ++k) { const int idx = (4 * (r + 1) + k) & 63; const int slot = (r + 1) < 16 ? __builtin_amdgcn_readlane(sl0, idx) : __builtin_amdgcn_readlane(sl1, idx); const unsigned char* yp = YP + (size_t)slot * D;
#pragma unroll
                            for (int jh = 0; jh < 2; ++jh) yn[k][jh] = *(const v2u*)(yp + 8 * lane + 512 * jh); }
#pragma unroll
                        for (int j = 0; j < 4; ++j) xn[j] = *(const f32x4*)(out + ro + D + 8 * lane + 512 * (j >> 1) + 4 * (j & 1));
                    }
                    f32x4 y[4];
#pragma unroll
                    for (int j = 0; j < 4; ++j) y[j] = (f32x4){0.f, 0.f, 0.f, 0.f};
#pragma unroll
                    for (int k = 0; k < 4; ++k)
#pragma unroll
                        for (int jh = 0; jh < 2; ++jh) { const v2u w = yc[k][jh];
                            const f32x2 a0 = __builtin_amdgcn_cvt_pk_f32_fp8((int)w.x, false), a1 = __builtin_amdgcn_cvt_pk_f32_fp8((int)w.x, true), a2 = __builtin_amdgcn_cvt_pk_f32_fp8((int)w.y, false), a3 = __builtin_amdgcn_cvt_pk_f32_fp8((int)w.y, true);
                            y[2 * jh].x += wk[k] * a0.x; y[2 * jh].y += wk[k] * a0.y; y[2 * jh].z += wk[k] * a1.x; y[2 * jh].w += wk[k] * a1.y;
                            y[2 * jh + 1].x += wk[k] * a2.x; y[2 * jh + 1].y += wk[k] * a2.y; y[2 * jh + 1].z += wk[k] * a3.x; y[2 * jh + 1].w += wk[k] * a3.y; }
                    float ss = 0.f;
#pragma unroll
                    for (int j = 0; j < 4; ++j) ss += (y[j].x * y[j].x + y[j].y * y[j].y) + (y[j].z * y[j].z + y[j].w * y[j].w);
                    const float rs = rsqrtf(wave_sum(ss) * (1.0f / D) + EPS);
#pragma unroll
                    for (int j = 0; j < 4; ++j) *(f32x4*)(out + ro + 8 * lane + 512 * (j >> 1) + 4 * (j & 1)) = xc4[j] + y[j] * rs * A3[j];
                }
            }
        }
    }
#undef IN
#undef SEAM
}
#undef x_in
#undef cvec
#undef positions
#undef w_ada
#undef b_ada
#undef g_pre_mix
#undef g_post_mix
#undef w_in
#undef b_in
#undef sinks
#undef conv_w
#undef conv_b
#undef w_rg
#undef b_rg
#undef w_ig
#undef b_ig
#undef lru_a
#undef w_out
#undef b_out
#undef g_pre_ffn
#undef g_post_ffn
#undef w_router
#undef b_router
#undef w_e1
#undef b_e1
#undef w_e2
#undef b_e2
#undef out
#undef MOD
#undef BINP
#undef LC
#undef WRT
#undef BE1P
#undef CNT
#undef WRGT
#undef WIGT
#undef NBLK
#undef BLKE
#undef TKI
#undef TKW
#undef TKP
#undef SLOT
#undef ROWTOK
#undef LP
#undef LH
#undef CS
#undef WBIN
#undef WBOUT
#undef HB
#undef PROJ
#undef MRG
#undef Y1
#undef WBE1
#undef WBE2
#undef YP
#undef H8
#undef ACT

extern "C" void kernel_launch(void* const* d_in, const int* in_sizes, int n_in, void* d_out, int out_size, void* d_ws, size_t ws_size, hipStream_t stream) {
    static int grid = 0;
    if (grid == 0) {
        if (n_in != 27 || out_size != T * D || ws_size < WS_END) { fprintf(stderr, "kernel_launch: unexpected shapes (n_in %d, out %d, ws %zu)\n", n_in, out_size, ws_size); grid = -1; return; }
        int dev = 0, cus = 0, per_cu = 0;
        if (hipGetDevice(&dev) != hipSuccess || hipDeviceGetAttribute(&cus, hipDeviceAttributeMultiprocessorCount, dev) != hipSuccess) { grid = -1; return; }
        if (hipFuncSetAttribute((const void*)fwd, hipFuncAttributeMaxDynamicSharedMemorySize, LDS_BYTES) != hipSuccess) { fprintf(stderr, "kernel_launch: hipFuncSetAttribute failed\n"); grid = -1; return; }
        if (hipOccupancyMaxActiveBlocksPerMultiprocessor(&per_cu, (const void*)fwd, NWAVES * 64, LDS_BYTES) != hipSuccess || per_cu < 1)
            fprintf(stderr, "kernel_launch: note: occupancy query reports %d workgroups per CU\n", per_cu);
        (void)hipGetLastError();
        grid = cus;
    }
    if (grid < 0) return;
    if (hipMemsetAsync((char*)d_ws + WS_CTL, 0, CTL_ZERO_BYTES, stream) != hipSuccess) return;
    Args a{};
    for (int i = 0; i < 27; ++i) a.in[i] = d_in[i];
    a.out = (float*)d_out; a.ws = (unsigned char*)d_ws;
    constexpr int NPH = 11;
    if (MK_N_LAUNCHES == 1) {
        a.ph_lo = 0; a.ph_hi = NPH;
        hipLaunchKernelGGL(fwd, dim3(grid), dim3(NWAVES * 64), LDS_BYTES, stream, a);
    } else {
        for (int p = 0; p < NPH; ++p) { a.ph_lo = p; a.ph_hi = p + 1; hipLaunchKernelGGL(fwd, dim3(grid), dim3(NWAVES * 64), LDS_BYTES, stream, a); }
    }
}
```
